# Optimizing an MI355X kernel written in HIP

```python
import math
import jax, jax.numpy as jnp
from jax import lax
import numpy as np

D_MODEL = 1024
BATCH = 16
SEQ = 2048
DEPTH = 1

D_MIX = D_MODEL
D_SSM = D_MIX // 2
SSM_GROUP = 16
N_SSM_GROUPS = D_SSM // SSM_GROUP
SSM_STATE = 64
D_ATTN = D_MIX - D_SSM
HEAD_DIM = 64
N_HEADS = D_ATTN // HEAD_DIM
Q_BLOCK = 128
D_FF = 2752
CONV_WIDTH = 3
EPS = 1e-6
DT_MIN = 1e-3
DT_MAX = 1e-1
D_IN_PROJ = D_SSM + 3 * D_ATTN + N_HEADS

kernel_name = "hymba_s5_fox_convffn_block"


def rmsnorm(x, g):
    xf = x.astype(jnp.float32)
    y = xf * lax.rsqrt(jnp.mean(xf * xf, axis=-1, keepdims=True) + EPS)
    return (y * g.astype(jnp.float32)).astype(x.dtype)


def s5_mixer(u, lam_re, lam_im, b_re, b_im, c_re, c_im, d_skip, log_dt, w_glu, b_glu):
    f32 = jnp.float32
    bsz, L, _ = u.shape
    uf = u.astype(f32).reshape(bsz, L, N_SSM_GROUPS, SSM_GROUP)
    lr = lam_re.astype(f32)
    li = lam_im.astype(f32)
    dt = jnp.exp(log_dt.astype(f32))[:, None]
    mag = jnp.exp(lr * dt)
    ab_re = mag * jnp.cos(li * dt)
    ab_im = mag * jnp.sin(li * dt)
    nr = ab_re - 1.0
    ni = ab_im
    den = lr * lr + li * li
    q_re = (nr * lr + ni * li) / den
    q_im = (ni * lr - nr * li) / den
    br = b_re.astype(f32)
    bi = b_im.astype(f32)
    bb_re = q_re[..., None] * br - q_im[..., None] * bi
    bb_im = q_re[..., None] * bi + q_im[..., None] * br
    bu_re = jnp.einsum('blgh,gph->blgp', uf, bb_re)
    bu_im = jnp.einsum('blgh,gph->blgp', uf, bb_im)
    a_re = jnp.broadcast_to(ab_re, (1, L) + ab_re.shape)
    a_im = jnp.broadcast_to(ab_im, (1, L) + ab_im.shape)

    def combine(e1, e2):
        a1r, a1i, b1r, b1i = e1
        a2r, a2i, b2r, b2i = e2
        return (a2r * a1r - a2i * a1i,
                a2r * a1i + a2i * a1r,
                a2r * b1r - a2i * b1i + b2r,
                a2r * b1i + a2i * b1r + b2i)

    _, _, xr, xi = lax.associative_scan(combine, (a_re, a_im, bu_re, bu_im), axis=1)
    y = (jnp.einsum('blgp,ghp->blgh', xr, c_re.astype(f32))
         - jnp.einsum('blgp,ghp->blgh', xi, c_im.astype(f32))
         + d_skip.astype(f32).reshape(N_SSM_GROUPS, SSM_GROUP) * uf)
    y = jax.nn.gelu(y.reshape(bsz, L, D_SSM))
    return y * jax.nn.sigmoid(y @ w_glu.astype(f32) + b_glu.astype(f32))


def fox_attention(q, k, v, f_logit):
    f32 = jnp.float32
    L = q.shape[1]
    log_f = jax.nn.log_sigmoid(f_logit.astype(f32))
    cum = jnp.cumsum(log_f, axis=1).transpose(0, 2, 1)
    scale = HEAD_DIM ** -0.5
    outs = []
    for i in range(L // Q_BLOCK):
        q0 = i * Q_BLOCK
        kend = q0 + Q_BLOCK
        qb = q[:, q0:kend]
        kb = k[:, :kend]
        vb = v[:, :kend]
        s = jnp.einsum('bqhd,bkhd->bhqk', qb, kb).astype(f32) * scale
        s = s + cum[:, :, q0:kend, None] - cum[:, :, None, :kend]
        mask = (q0 + jnp.arange(Q_BLOCK))[:, None] >= jnp.arange(kend)[None, :]
        s = jnp.where(mask, s, -jnp.inf)
        p = jax.nn.softmax(s, axis=-1)
        outs.append(jnp.einsum('bhqk,bkhd->bqhd', p.astype(v.dtype), vb))
    return jnp.concatenate(outs, axis=1)


def conv_ffn(h, w_up, conv_w, conv_b, w_down):
    u = h @ w_up
    L = u.shape[1]
    up = jnp.pad(u, ((0, 0), (CONV_WIDTH - 1, 0), (0, 0)))
    c = up[:, 0:L] * conv_w[0]
    for kk in range(1, CONV_WIDTH):
        c = c + up[:, kk:kk + L] * conv_w[kk]
    c = c + conv_b
    gate, val = jnp.split(c, 2, axis=-1)
    return (jax.nn.silu(gate) * val) @ w_down


def setup_inputs(seed: int = 0) -> dict:
    key = jax.random.key(seed)
    ks = jax.random.split(key, 24)
    f32 = jnp.float32
    nrm = lambda k, shape, s: jax.random.normal(k, shape, f32) * s
    G, P, H = N_SSM_GROUPS, SSM_STATE, SSM_GROUP
    x = jax.random.normal(ks[0], (BATCH, SEQ, D_MODEL), f32)
    norm_mix = 1.0 + nrm(ks[1], (DEPTH, D_MODEL), 0.02)
    w_in = nrm(ks[2], (DEPTH, D_MODEL, D_IN_PROJ), D_MODEL ** -0.5)
    b_forget = jax.random.uniform(ks[3], (DEPTH, N_HEADS), f32, 1.0, 5.0)
    lam_re = -0.5 + nrm(ks[4], (DEPTH, G, P), 0.01)
    lam_im = jnp.pi * jnp.arange(P, dtype=f32)[None, None, :] + nrm(ks[5], (DEPTH, G, P), 0.01)
    b_re = nrm(ks[6], (DEPTH, G, P, H), (2.0 * H) ** -0.5)
    b_im = nrm(ks[7], (DEPTH, G, P, H), (2.0 * H) ** -0.5)
    c_re = nrm(ks[8], (DEPTH, G, H, P), (2.0 * P) ** -0.5)
    c_im = nrm(ks[9], (DEPTH, G, H, P), (2.0 * P) ** -0.5)
    d_skip = nrm(ks[10], (DEPTH, D_SSM), 1.0)
    log_dt = jax.random.uniform(ks[11], (DEPTH, G), f32, math.log(DT_MIN), math.log(DT_MAX))
    w_glu = nrm(ks[12], (DEPTH, D_SSM, D_SSM), D_SSM ** -0.5)
    b_glu = nrm(ks[13], (DEPTH, D_SSM), 0.01)
    q_norm = 1.0 + nrm(ks[14], (DEPTH, HEAD_DIM), 0.02)
    k_norm = 1.0 + nrm(ks[15], (DEPTH, HEAD_DIM), 0.02)
    norm_out_ssm = 1.0 + nrm(ks[16], (DEPTH, D_SSM), 0.02)
    norm_out_attn = 1.0 + nrm(ks[17], (DEPTH, D_ATTN), 0.02)
    w_out = nrm(ks[18], (DEPTH, D_MIX, D_MODEL), D_MIX ** -0.5)
    norm_ffn = 1.0 + nrm(ks[19], (DEPTH, D_MODEL), 0.02)
    w_up = nrm(ks[20], (DEPTH, D_MODEL, 2 * D_FF), D_MODEL ** -0.5)
    conv_w = nrm(ks[21], (DEPTH, CONV_WIDTH, 2 * D_FF), CONV_WIDTH ** -0.5)
    conv_b = nrm(ks[22], (DEPTH, 2 * D_FF), 0.01)
    w_down = nrm(ks[23], (DEPTH, D_FF, D_MODEL), D_FF ** -0.5)
    return {"x": x, "norm_mix": norm_mix, "w_in": w_in, "b_forget": b_forget,
            "lam_re": lam_re, "lam_im": lam_im, "b_re": b_re, "b_im": b_im,
            "c_re": c_re, "c_im": c_im, "d_skip": d_skip, "log_dt": log_dt,
            "w_glu": w_glu, "b_glu": b_glu, "q_norm": q_norm, "k_norm": k_norm,
            "norm_out_ssm": norm_out_ssm, "norm_out_attn": norm_out_attn,
            "w_out": w_out, "norm_ffn": norm_ffn, "w_up": w_up, "conv_w": conv_w,
            "conv_b": conv_b, "w_down": w_down}


def reference(x, norm_mix, w_in, b_forget, lam_re, lam_im, b_re, b_im, c_re, c_im,
              d_skip, log_dt, w_glu, b_glu, q_norm, k_norm, norm_out_ssm,
              norm_out_attn, w_out, norm_ffn, w_up, conv_w, conv_b, w_down):
    bsz, L, _ = x.shape
    h = x
    for l in range(DEPTH):
        hn = rmsnorm(h, norm_mix[l])
        proj = hn @ w_in[l]
        o = 0
        u_ssm = proj[..., o:o + D_SSM]; o += D_SSM
        q = proj[..., o:o + D_ATTN].reshape(bsz, L, N_HEADS, HEAD_DIM); o += D_ATTN
        k = proj[..., o:o + D_ATTN].reshape(bsz, L, N_HEADS, HEAD_DIM); o += D_ATTN
        v = proj[..., o:o + D_ATTN].reshape(bsz, L, N_HEADS, HEAD_DIM); o += D_ATTN
        f_logit = proj[..., o:o + N_HEADS] + b_forget[l]

        y_ssm = s5_mixer(u_ssm, lam_re[l], lam_im[l], b_re[l], b_im[l], c_re[l],
                         c_im[l], d_skip[l], log_dt[l], w_glu[l], b_glu[l]).astype(h.dtype)
        q = rmsnorm(q, q_norm[l])
        k = rmsnorm(k, k_norm[l])
        y_attn = fox_attention(q, k, v, f_logit).reshape(bsz, L, D_ATTN)

        mixed = jnp.concatenate([rmsnorm(y_ssm, norm_out_ssm[l]),
                                 rmsnorm(y_attn, norm_out_attn[l])], axis=-1)
        h = h + mixed @ w_out[l]
        h = h + conv_ffn(rmsnorm(h, norm_ffn[l]), w_up[l], conv_w[l], conv_b[l], w_down[l])
    return h
```

```cpp
#include <hip/hip_runtime.h>
#include <hip/hip_cooperative_groups.h>
#include <cstdio>
#include <cstdint>
__device__ __forceinline__ int fresh_tid(int widx) { int l; asm volatile("v_mbcnt_lo_u32_b32 %0, -1, 0\n\tv_mbcnt_hi_u32_b32 %0, -1, %0" : "=v"(l)); return widx * 64 + l; }
namespace pg8 {
#define PG8_LAS __attribute__((address_space(3)))
typedef unsigned short bf16_t;
typedef short bf16x8 __attribute__((ext_vector_type(8)));
typedef float f32x4 __attribute__((ext_vector_type(4)));
typedef unsigned u32x4 __attribute__((ext_vector_type(4)));
constexpr int BM = 256, BK = 64, HALF = 128, HTB = HALF * BK * 2  , STAGE_BYTES = 8 * HTB, NXCD = 8, WGM = 8;

__host__ __device__ __forceinline__ int lds_byte(int r, int c) { const int st = (r >> 4) * 2 + (c >> 5), rr = r & 15, cc = c & 31, ob = rr * 64 + cc * 2; return st * 1024 + (ob ^ (((ob >> 9) & 1) << 5)); }
__host__ __device__ __forceinline__ void stage_rc(int b, int& R, int& C) { const int st = b / 1024, sb = b % 1024, swz = sb ^ (((sb >> 9) & 1) << 5); R = (st >> 1) * 16 + swz / 64; C = (st & 1) * 32 + (swz % 64) / 2; }
__host__ __device__ __forceinline__ int perm32(int rho) { const int n = rho >> 4, i = rho & 15; return 8 * (i >> 2) + 4 * n + (i & 3); }

struct Unit { int pm, pn, pb; };
struct Gemm { const bf16_t* A; const bf16_t* Bt; int K, lda, ldb; size_t sA, sB; int agm = 0; };

struct StaticOrder {
    int nM, nN, nwg, G, c;
    __host__ __device__ void init(int M, int N, int G_, int c_) { nM = M / BM; nN = N / BM; nwg = nM * nN; G = G_; c = c_; }
    __host__ __device__ bool next(int i, Unit& u) const {
        const long L = (long)i * G + c; if (L >= nwg) return false;
        int wgid = (int)L; { const int q = nwg / NXCD, r = nwg % NXCD, xcd = wgid % NXCD, off = wgid / NXCD; wgid = (xcd < r ? xcd * (q + 1) : r * (q + 1) + (xcd - r) * q) + off; }
        const int nig = WGM * nN, gid = wgid / nig, fm = gid * WGM, gsz = (nM - fm) < WGM ? (nM - fm) : WGM;
        u.pm = fm + ((wgid % nig) % gsz); u.pn = (wgid % nig) / gsz; u.pb = 0; return true;
    }
    __device__ __forceinline__ void a_ready(const Unit&) const {}
    __device__ __forceinline__ void done(const Unit&) const {}
};

__device__ __forceinline__ unsigned cvt_pk_bf16(float lo, float hi) { unsigned r; asm volatile("v_cvt_pk_bf16_f32 %0, %1, %2" : "=v"(r) : "v"(lo), "v"(hi)); return r; }
typedef float f32x2 __attribute__((ext_vector_type(2)));
__device__ __forceinline__ f32x2 gelu_pk(f32x2 v) {
    const f32x2 av = __builtin_elementwise_abs(v), d = av * 0.2316418882f + 1.0f;
    f32x2 t; t.x = __builtin_amdgcn_rcpf(d.x); t.y = __builtin_amdgcn_rcpf(d.y);
    f32x2 q = t * 0.5307027145f + (-0.7265760135f); q = q * t + 0.7107068705f; q = q * t + (-0.142248368f); q = q * t + 0.127414796f; q = q * t;
    const f32x2 s = (v * v) * (-0.72134752044f);
    f32x2 e; e.x = __builtin_amdgcn_exp2f(s.x); e.y = __builtin_amdgcn_exp2f(s.y);
    const f32x2 m = v * (q * e), r = v - m;
    f32x2 o; o.x = v.x < 0.f ? m.x : r.x; o.y = v.y < 0.f ? m.y : r.y; return o;
}

template <int ACT  > struct EpiBf16 {
    static constexpr bool PERM = true, AFTER_DRAIN = false; static_assert(ACT == 0 || ACT == 1, "EpiBf16: ACT is 0 (none) or 1 (gelu_pk)");
    bf16_t* O; int ldc; const float* bias; int split_cols; size_t split_stride; float scale0;
    __device__ __forceinline__ void operator()(const f32x4 (&acc)[2][2][4][2], const Unit& u, int wr, int wc, int fr, int fq) const {
        const int row0 = u.pm * BM + wr * 64 + fr; int colt = u.pn * BM; bf16_t* base = O;
        float sc = 1.f; if (split_cols) { const int t = colt / split_cols; base += (size_t)t * split_stride; colt -= t * split_cols; if (t == 0) sc = scale0; }
        const int col0 = colt + wc * 32 + 8 * fq, bcol0 = u.pn * BM + wc * 32 + 8 * fq;
        f32x4 bv[2][2];
#pragma unroll
        for (int bj = 0; bj < 2; ++bj)
#pragma unroll
            for (int n = 0; n < 2; ++n) bv[bj][n] = bias ? *(const f32x4*)(bias + bcol0 + bj * HALF + 4 * n) : (f32x4){0.f, 0.f, 0.f, 0.f};
#pragma unroll
        for (int ai = 0; ai < 2; ++ai)
#pragma unroll
            for (int m = 0; m < 4; ++m) { bf16_t* rowp = base + (size_t)(row0 + ai * HALF + m * 16) * ldc + col0;
#pragma unroll
                for (int bj = 0; bj < 2; ++bj) { f32x4 v0 = acc[ai][bj][m][0] + bv[bj][0], v1 = acc[ai][bj][m][1] + bv[bj][1];
                    if (ACT == 1) { f32x2 a = gelu_pk((f32x2){v0[0], v0[1]}), b = gelu_pk((f32x2){v0[2], v0[3]}), c = gelu_pk((f32x2){v1[0], v1[1]}), d = gelu_pk((f32x2){v1[2], v1[3]});
                        v0 = (f32x4){a.x, a.y, b.x, b.y}; v1 = (f32x4){c.x, c.y, d.x, d.y}; }
                    v0 = v0 * sc; v1 = v1 * sc; u32x4 w; w.x = cvt_pk_bf16(v0[0], v0[1]); w.y = cvt_pk_bf16(v0[2], v0[3]); w.z = cvt_pk_bf16(v1[0], v1[1]); w.w = cvt_pk_bf16(v1[2], v1[3]);
                    *(u32x4*)(rowp + bj * HALF) = w; } }
    }
};
__device__ __forceinline__ float fast_sigmoid(float z) { return __builtin_amdgcn_rcpf(1.0f + __builtin_amdgcn_exp2f(-1.4426950408889634f * z)); }
__device__ __forceinline__ float gelu_tanh(float v) { const float z = 1.5957691216057308f * (v + 0.044715f * v * v * v); return v * fast_sigmoid(z); }
__device__ __forceinline__ u32x4 pack8(const f32x4& a, const f32x4& b) { u32x4 w; w.x = cvt_pk_bf16(a[0], a[1]); w.y = cvt_pk_bf16(a[2], a[3]); w.z = cvt_pk_bf16(b[0], b[1]); w.w = cvt_pk_bf16(b[2], b[3]); return w; }
__device__ __forceinline__ float bf_lo(unsigned w) { return __uint_as_float(w << 16); }
__device__ __forceinline__ float bf_hi(unsigned w) { return __uint_as_float(w & 0xffff0000u); }

struct EpiProj { static constexpr bool PERM = true, AFTER_DRAIN = false;
    bf16_t* Ucat; bf16_t* Q; bf16_t* Kb; bf16_t* V; const float* qn; const float* kn;
    __device__ __forceinline__ void operator()(const f32x4 (&acc)[2][2][4][2], const Unit& u, int wr, int wc, int fr, int fq) const {
        const int row0 = u.pm * BM + wr * 64 + fr, sect = u.pn >> 1;
        if (sect == 1 || sect == 2) {
            const float* gp = (sect == 1 ? qn : kn) + 8 * fq; const float sc = sect == 1 ? 0.125f * 1.4426950408889634f : 1.f;
            const f32x4 g00 = *(const f32x4*)(gp), g01 = *(const f32x4*)(gp + 4), g10 = *(const f32x4*)(gp + 32), g11 = *(const f32x4*)(gp + 36);
            bf16_t* dst = Q + (size_t)(sect - 1) * ((size_t)32768 * 512) + (u.pn & 1) * 256 + 64 * wc + 8 * fq;
#pragma unroll
            for (int ai = 0; ai < 2; ++ai)
#pragma unroll
                for (int m = 0; m < 4; ++m) { const int row = row0 + ai * HALF + m * 16;
                    const f32x4 a0 = acc[ai][0][m][0], a1 = acc[ai][0][m][1], b0 = acc[ai][1][m][0], b1 = acc[ai][1][m][1];
                    float s = ((a0[0] * a0[0] + a0[1] * a0[1]) + (a0[2] * a0[2] + a0[3] * a0[3])) + ((a1[0] * a1[0] + a1[1] * a1[1]) + (a1[2] * a1[2] + a1[3] * a1[3]))
                            + ((b0[0] * b0[0] + b0[1] * b0[1]) + (b0[2] * b0[2] + b0[3] * b0[3])) + ((b1[0] * b1[0] + b1[1] * b1[1]) + (b1[2] * b1[2] + b1[3] * b1[3]));
                    s += __shfl_xor(s, 16); s += __shfl_xor(s, 32);
                    const float rs = sc / sqrtf(s * (1.f / 64.f) + 1e-6f);
                    *(u32x4*)(dst + (size_t)row * 512) = pack8(a0 * rs * g00, a1 * rs * g01);
                    *(u32x4*)(dst + (size_t)row * 512 + 32) = pack8(b0 * rs * g10, b1 * rs * g11); }
            return;
        }
        const int colb = (u.pn & 1) * 256 + wc * 32 + 8 * fq;
#pragma unroll
        for (int ai = 0; ai < 2; ++ai)
#pragma unroll
            for (int m = 0; m < 4; ++m) { const int row = row0 + ai * HALF + m * 16;
#pragma unroll
                for (int bj = 0; bj < 2; ++bj) { const int col = colb + bj * HALF; const u32x4 w = pack8(acc[ai][bj][m][0], acc[ai][bj][m][1]);
                    if (sect == 0) { const int g = col >> 4, hf = (col >> 3) & 1; *(u32x4*)(Ucat + ((size_t)(g * 2048 + (row >> 4)) * 256 + (row & 15) * 16 + hf * 8)) = w; }
                    else *(u32x4*)(V + (size_t)row * 512 + col) = w; } }
    }
};
struct EpiSloc { static constexpr bool PERM = false, AFTER_DRAIN = false;
    float* S;
    __device__ __forceinline__ void operator()(const f32x4 (&acc)[2][2][4][2], const Unit& u, int wr, int wc, int fr, int fq) const {
        const int row0 = u.pm * BM + wr * 64 + fr, col0 = wc * 32 + 4 * fq;
#pragma unroll
        for (int ai = 0; ai < 2; ++ai)
#pragma unroll
            for (int m = 0; m < 4; ++m) { float* rp = S + ((size_t)u.pb * 2048 + row0 + ai * HALF + m * 16) * 128 + col0;
#pragma unroll
                for (int n = 0; n < 2; ++n) *(f32x4*)(rp + 16 * n) = acc[ai][0][m][n]; }
    }
};
struct EpiSsm { static constexpr bool PERM = true, AFTER_DRAIN = false;
    bf16_t* Y;
    __device__ __forceinline__ void operator()(const f32x4 (&acc)[2][2][4][2], const Unit& u, int wr, int wc, int fr, int fq) const {
        const int row0 = u.pm * BM + wr * 64 + fr, colb = wc * 32 + 8 * fq;
#pragma unroll
        for (int ai = 0; ai < 2; ++ai)
#pragma unroll
            for (int m = 0; m < 4; ++m) { const int c = row0 + ai * HALF + m * 16;
#pragma unroll
                for (int bj = 0; bj < 2; ++bj) { const int col = colb + bj * HALF, t = col >> 4, h0 = col & 15;
                    f32x4 a = acc[ai][bj][m][0], b = acc[ai][bj][m][1];
#pragma unroll
                    for (int i = 0; i < 4; ++i) { a[i] = gelu_tanh(a[i]); b[i] = gelu_tanh(b[i]); }
                    *(u32x4*)(Y + (size_t)(16 * c + t) * 512 + 16 * u.pb + h0) = pack8(a, b); } }
    }
};
struct EpiGlu { static constexpr bool PERM = true, AFTER_DRAIN = false;
    const bf16_t* Y; bf16_t* O; const float* bias; float* ssa;
    __device__ __forceinline__ void operator()(const f32x4 (&acc)[2][2][4][2], const Unit& u, int wr, int wc, int fr, int fq) const {
        const int row0 = u.pm * BM + wr * 64 + fr, colb = u.pn * BM + wc * 32 + 8 * fq;
        f32x4 b0[2], b1[2];
#pragma unroll
        for (int bj = 0; bj < 2; ++bj) { b0[bj] = *(const f32x4*)(bias + colb + bj * HALF); b1[bj] = *(const f32x4*)(bias + colb + bj * HALF + 4); }
#pragma unroll
        for (int ai = 0; ai < 2; ++ai)
#pragma unroll
            for (int m = 0; m < 4; ++m) { const int row = row0 + ai * HALF + m * 16; float s = 0.f;
#pragma unroll
                for (int bj = 0; bj < 2; ++bj) { const int col = colb + bj * HALF; const u32x4 yv = *(const u32x4*)(Y + ((size_t)(col >> 4) * 32768 + row) * 16 + (col & 15));
                    f32x4 a = acc[ai][bj][m][0] + b0[bj], b = acc[ai][bj][m][1] + b1[bj];
                    a[0] = bf_lo(yv.x) * fast_sigmoid(a[0]); a[1] = bf_hi(yv.x) * fast_sigmoid(a[1]); a[2] = bf_lo(yv.y) * fast_sigmoid(a[2]); a[3] = bf_hi(yv.y) * fast_sigmoid(a[3]);
                    b[0] = bf_lo(yv.z) * fast_sigmoid(b[0]); b[1] = bf_hi(yv.z) * fast_sigmoid(b[1]); b[2] = bf_lo(yv.w) * fast_sigmoid(b[2]); b[3] = bf_hi(yv.w) * fast_sigmoid(b[3]);
                    s += ((a[0] * a[0] + a[1] * a[1]) + (a[2] * a[2] + a[3] * a[3])) + ((b[0] * b[0] + b[1] * b[1]) + (b[2] * b[2] + b[3] * b[3]));
                    *(u32x4*)(O + (size_t)row * 1024 + col) = pack8(a, b); }
                s += __shfl_xor(s, 16); s += __shfl_xor(s, 32);
                if (fq == 0) ssa[(size_t)row * 8 + u.pn * 4 + wc] = s; }
    }
};
struct EpiRes { static constexpr bool PERM = false, AFTER_DRAIN = false;
    const float* base; float* out;
    __device__ __forceinline__ void operator()(const f32x4 (&acc)[2][2][4][2], const Unit& u, int wr, int wc, int fr, int fq) const {
        const int row0 = u.pm * BM + wr * 64 + fr, col0 = u.pn * BM + wc * 32 + 4 * fq;
#pragma unroll
        for (int ai = 0; ai < 2; ++ai)
#pragma unroll
            for (int m = 0; m < 4; ++m) { const size_t off = (size_t)(row0 + ai * HALF + m * 16) * 1024 + col0;
#pragma unroll
                for (int bj = 0; bj < 2; ++bj)
#pragma unroll
                    for (int n = 0; n < 2; ++n) { const f32x4 bs = *(const f32x4*)(base + off + bj * HALF + n * 16); *(f32x4*)(out + off + bj * HALF + n * 16) = bs + acc[ai][bj][m][n]; } }
    }
};

template <int CTRL> __device__ __forceinline__ float dpp_f(float v) { return __int_as_float(__builtin_amdgcn_update_dpp(0, __float_as_int(v), CTRL, 0xF, 0xF, true)); }
__device__ __forceinline__ f32x4 sigmoid4(const f32x4 z) { f32x4 r; r[0] = fast_sigmoid(z[0]); r[1] = fast_sigmoid(z[1]); r[2] = fast_sigmoid(z[2]); r[3] = fast_sigmoid(z[3]); return r; }
struct EpiUpConv { static constexpr bool PERM = true, AFTER_DRAIN = false, ROWPERM = true;
    bf16_t* ACT; bf16_t* RAW; const float* cw; const float* cb; const float* ss;
    __device__ __forceinline__ void operator()(f32x4 (&acc)[2][2][4][2], const Unit& u, int wr, int wc, int fr, int fq) const {
        const int J0 = u.pn * 128 + wc * 32 + 8 * fq;
        const int tok0 = u.pm * BM + wr * 128 + fr * 8;
        {
            const f32x4 r0 = *(const f32x4*)(ss + tok0), r1 = *(const f32x4*)(ss + tok0 + 4);
#pragma unroll
            for (int m = 0; m < 4; ++m)
#pragma unroll
                for (int bj = 0; bj < 2; ++bj)
#pragma unroll
                    for (int n = 0; n < 2; ++n) { acc[0][bj][m][n] *= r0[m]; acc[1][bj][m][n] *= r1[m]; }
        }
        if (fr == 0) { bf16_t* rp = RAW + ((size_t)u.pm * 8 + wr * 4) * 5632 + J0;
            *(u32x4*)(rp) = pack8(acc[0][0][0][0], acc[0][0][0][1]); *(u32x4*)(rp + 2816) = pack8(acc[0][1][0][0], acc[0][1][0][1]);
            *(u32x4*)(rp + 5632) = pack8(acc[0][0][1][0], acc[0][0][1][1]); *(u32x4*)(rp + 5632 + 2816) = pack8(acc[0][1][1][0], acc[0][1][1][1]); }
        if (fr == 15) { bf16_t* rp = RAW + ((size_t)u.pm * 8 + wr * 4 + 2) * 5632 + J0;
            *(u32x4*)(rp) = pack8(acc[1][0][2][0], acc[1][0][2][1]); *(u32x4*)(rp + 2816) = pack8(acc[1][1][2][0], acc[1][1][2][1]);
            *(u32x4*)(rp + 5632) = pack8(acc[1][0][3][0], acc[1][0][3][1]); *(u32x4*)(rp + 5632 + 2816) = pack8(acc[1][1][3][0], acc[1][1][3][1]); }
#pragma unroll
        for (int n = 0; n < 2; ++n) {
            const int Jn = J0 + 4 * n; const bool ok = Jn < 2752; const f32x4 z4 = (f32x4){0.f, 0.f, 0.f, 0.f};
            const f32x4 w0g = ok ? *(const f32x4*)(cw + Jn) : z4, w1g = ok ? *(const f32x4*)(cw + 5504 + Jn) : z4, w2g = ok ? *(const f32x4*)(cw + 2 * 5504 + Jn) : z4, bg = ok ? *(const f32x4*)(cb + Jn) : z4;
            const f32x4 w0v = ok ? *(const f32x4*)(cw + 2752 + Jn) : z4, w1v = ok ? *(const f32x4*)(cw + 5504 + 2752 + Jn) : z4, w2v = ok ? *(const f32x4*)(cw + 2 * 5504 + 2752 + Jn) : z4, bv = ok ? *(const f32x4*)(cb + 2752 + Jn) : z4;
            f32x4 h2g, h1g, h2v, h1v;
#pragma unroll
            for (int i = 0; i < 4; ++i) { h2g[i] = dpp_f<0x111>(acc[1][0][2][n][i]); h1g[i] = dpp_f<0x111>(acc[1][0][3][n][i]); h2v[i] = dpp_f<0x111>(acc[1][1][2][n][i]); h1v[i] = dpp_f<0x111>(acc[1][1][3][n][i]); }
#pragma unroll
            for (int jj = 0; jj < 8; ++jj) { const int j = 7 - jj;
                const f32x4 g0 = acc[j >> 2][0][j & 3][n], v0 = acc[j >> 2][1][j & 3][n];
                const f32x4 g1 = j >= 1 ? acc[(j >= 1 ? j - 1 : 0) >> 2][0][(j >= 1 ? j - 1 : 0) & 3][n] : h1g, v1 = j >= 1 ? acc[(j >= 1 ? j - 1 : 0) >> 2][1][(j >= 1 ? j - 1 : 0) & 3][n] : h1v;
                const f32x4 g2 = j >= 2 ? acc[(j >= 2 ? j - 2 : 0) >> 2][0][(j >= 2 ? j - 2 : 0) & 3][n] : (j == 1 ? h1g : h2g), v2 = j >= 2 ? acc[(j >= 2 ? j - 2 : 0) >> 2][1][(j >= 2 ? j - 2 : 0) & 3][n] : (j == 1 ? h1v : h2v);
                const f32x4 og = w0g * g2 + w1g * g1 + w2g * g0 + bg, ov = w0v * v2 + w1v * v1 + w2v * v0 + bv;
                acc[j >> 2][0][j & 3][n] = og * sigmoid4(og) * ov; }
        }
#pragma unroll
        for (int ai = 0; ai < 2; ++ai)
#pragma unroll
            for (int m = 0; m < 4; ++m) *(u32x4*)(ACT + (size_t)(tok0 + 4 * ai + m) * 2816 + J0) = pack8(acc[ai][0][m][0], acc[ai][0][m][1]);
    }
};

struct EpiResSq { static constexpr bool PERM = true, AFTER_DRAIN = false, MIDK = true;
    const float* base; float* out; bf16_t* hb; float* ss; const float* ratio; const float* rs2; const float* irs0; const float* gmix;
    __device__ __forceinline__ void midk(f32x4 (&acc)[2][2][4][2], const Unit& u, int wr, int wc, int fr, int fq) const {
        const int row0 = u.pm * BM + wr * 64 + fr;
#pragma unroll
        for (int ai = 0; ai < 2; ++ai)
#pragma unroll
            for (int m = 0; m < 4; ++m) { const float r = ratio[row0 + ai * HALF + m * 16];
#pragma unroll
                for (int bj = 0; bj < 2; ++bj)
#pragma unroll
                    for (int n = 0; n < 2; ++n) acc[ai][bj][m][n] *= r; }
    }
    __device__ __forceinline__ void operator()(const f32x4 (&acc)[2][2][4][2], const Unit& u, int wr, int wc, int fr, int fq) const {
        const int row0 = u.pm * BM + wr * 64 + fr, col0 = u.pn * BM + wc * 32 + 8 * fq;
        f32x4 gi[2][2];
#pragma unroll
        for (int bj = 0; bj < 2; ++bj)
#pragma unroll
            for (int n = 0; n < 2; ++n) { const f32x4 gv = *(const f32x4*)(gmix + col0 + bj * HALF + 4 * n); gi[bj][n] = (f32x4){__builtin_amdgcn_rcpf(gv[0]), __builtin_amdgcn_rcpf(gv[1]), __builtin_amdgcn_rcpf(gv[2]), __builtin_amdgcn_rcpf(gv[3])}; }
#pragma unroll
        for (int ai = 0; ai < 2; ++ai)
#pragma unroll
            for (int m = 0; m < 4; ++m) { const int row = row0 + ai * HALF + m * 16; const size_t off = (size_t)row * 1024 + col0; float s = 0.f; const float r2 = rs2[row], ir = irs0[row];
#pragma unroll
                for (int bj = 0; bj < 2; ++bj) { const u32x4 xv = *(const u32x4*)(hb + off + bj * HALF);
                    const f32x4 x0 = (f32x4){bf_lo(xv.x), bf_hi(xv.x), bf_lo(xv.y), bf_hi(xv.y)} * gi[bj][0] * ir, x1 = (f32x4){bf_lo(xv.z), bf_hi(xv.z), bf_lo(xv.w), bf_hi(xv.w)} * gi[bj][1] * ir;
                    const f32x4 h0 = x0 + acc[ai][bj][m][0] * r2, h1 = x1 + acc[ai][bj][m][1] * r2;
                    s += ((h0[0] * h0[0] + h0[1] * h0[1]) + (h0[2] * h0[2] + h0[3] * h0[3])) + ((h1[0] * h1[0] + h1[1] * h1[1]) + (h1[2] * h1[2] + h1[3] * h1[3]));
                    *(u32x4*)(hb + off + bj * HALF) = pack8(h0, h1); }
                s += __shfl_xor(s, 16); s += __shfl_xor(s, 32);
                if (fq == 0) ss[(size_t)row * 16 + u.pn * 4 + wc] = s; }
    }
};

struct EpiResB { static constexpr bool PERM = false, AFTER_DRAIN = false;
    const bf16_t* base; float* out;
    __device__ __forceinline__ void operator()(const f32x4 (&acc)[2][2][4][2], const Unit& u, int wr, int wc, int fr, int fq) const {
        typedef unsigned u32x2 __attribute__((ext_vector_type(2)));
        const int row0 = u.pm * BM + wr * 64 + fr, col0 = u.pn * BM + wc * 32 + 4 * fq;
#pragma unroll
        for (int ai = 0; ai < 2; ++ai)
#pragma unroll
            for (int m = 0; m < 4; ++m) { const size_t off = (size_t)(row0 + ai * HALF + m * 16) * 1024 + col0;
#pragma unroll
                for (int bj = 0; bj < 2; ++bj)
#pragma unroll
                    for (int n = 0; n < 2; ++n) { const u32x2 w = *(const u32x2*)(base + off + bj * HALF + n * 16); const f32x4 bs = (f32x4){bf_lo(w.x), bf_hi(w.x), bf_lo(w.y), bf_hi(w.y)};
                        *(f32x4*)(out + off + bj * HALF + n * 16) = bs + acc[ai][bj][m][n]; } }
    }
};
struct BatchOrder {
    int nM, total, G, c;
    __host__ __device__ void init(int nB, int nM_, int G_, int c_) { nM = nM_; total = nB * nM_; G = G_; c = c_; }
    __host__ __device__ bool next(int i, Unit& u) const { const int L = i * G + c; if (L >= total) return false; u.pb = L / nM; u.pm = L % nM; u.pn = 0; return true; }
    __device__ __forceinline__ void a_ready(const Unit&) const {}
    __device__ __forceinline__ void done(const Unit&) const {}
};
struct OneUnit { int pb, pm;
    __host__ __device__ bool next(int i, Unit& u) const { if (i) return false; u.pb = pb; u.pm = pm; u.pn = 0; return true; }
    __device__ __forceinline__ void a_ready(const Unit&) const {}
    __device__ __forceinline__ void done(const Unit&) const {}
};
template <class Epi, class = void> struct epi_rowperm_t { static constexpr bool value = false; };
template <class Epi> struct epi_rowperm_t<Epi, decltype((void)Epi::ROWPERM)> { static constexpr bool value = Epi::ROWPERM; };
template <class Epi> __host__ __device__ constexpr bool epi_rowperm() { return epi_rowperm_t<Epi>::value; }
template <class Epi, class = void> struct epi_midk_t { static constexpr bool value = false; };
template <class Epi> struct epi_midk_t<Epi, decltype((void)Epi::MIDK)> { static constexpr bool value = Epi::MIDK; };
template <class Epi, class Sched, bool ALIGN_EPI = false, bool SP2 = false>
__device__ __forceinline__ void gemm_phase(PG8_LAS unsigned char* lds, const Gemm g, const Sched& S, const Epi& E, const int widx) {
    const int tid = fresh_tid(widx), wid = __builtin_amdgcn_readfirstlane(tid >> 6), lane = tid & 63, wr = wid >> 2, wc = wid & 3, fr = lane & 15, fq = lane >> 4;
    const int K = g.K, nt = K / BK;
    unsigned voffA[2], voffB[2];
#pragma unroll
    for (int i = 0; i < 2; ++i) { int R, C; stage_rc(tid * 16 + i * 8192, R, C); const int Rb = Epi::PERM ? ((R & ~31) + perm32(R & 31)) : R;
        voffA[i] = g.agm ? (unsigned)(((C >> 4) * g.agm + R) * 16 + (C & 15)) * 2u : (unsigned)((epi_rowperm<Epi>() ? (128 * (R >> 6) + 8 * (R & 15) + ((R >> 4) & 3)) : R) * g.lda + C) * 2u; voffB[i] = (unsigned)(Rb * g.ldb + C) * 2u; }
    const size_t kstep = (size_t)(BK * 2);
    const size_t kstepA = g.agm ? (size_t)4 * g.agm * 32 : kstep;
    const size_t hstepA = g.agm ? (size_t)HALF * 32 : (size_t)(epi_rowperm<Epi>() ? 4 : HALF) * g.lda * 2, hstepB = (size_t)HALF * g.ldb * 2;
    const size_t tstepA = g.agm ? (size_t)BM * 32 : (size_t)BM * g.lda * 2, tstepB = 2 * hstepB;
    const unsigned ldsw = (unsigned)wid * 1024u;
    const int aoff = lds_byte(wr * 64 + fr, fq * 8), boff = lds_byte(wc * 32 + fr, fq * 8);
#define PG8_SA(b, h) (((b) * 2 + (h)) * HTB)
#define PG8_SB(b, h) ((4 + (b) * 2 + (h)) * HTB)
#define PG8_STAGE(bufoff, gbase, voff) do { _Pragma("unroll") for (int _i = 0; _i < 2; ++_i) \
        __builtin_amdgcn_global_load_lds((const unsigned*)((const char*)(gbase) + (voff)[_i]), (PG8_LAS unsigned*)(lds + (bufoff) + ldsw + _i * 8192), 16, 0, 0); } while (0)
#define PG8_LDA(dst, b, h) do { _Pragma("unroll") for (int m = 0; m < 4; ++m) _Pragma("unroll") for (int k = 0; k < 2; ++k) dst[m][k] = *(const PG8_LAS bf16x8*)(lds + PG8_SA(b, h) + aoff + m * 2048 + k * 1024); } while (0)
#define PG8_LDB(dst, b, h) do { _Pragma("unroll") for (int n = 0; n < 2; ++n) _Pragma("unroll") for (int k = 0; k < 2; ++k) dst[n][k] = *(const PG8_LAS bf16x8*)(lds + PG8_SB(b, h) + boff + n * 2048 + k * 1024); } while (0)
#define PG8_MMA(ai, bj, At, Bt) do { __builtin_amdgcn_s_setprio(1); _Pragma("unroll") for (int m = 0; m < 4; ++m) _Pragma("unroll") for (int n = 0; n < 2; ++n) _Pragma("unroll") for (int k = 0; k < 2; ++k) \
        acc[ai][bj][m][n] = __builtin_amdgcn_mfma_f32_16x16x32_bf16(Bt[n][k], At[m][k], acc[ai][bj][m][n], 0, 0, 0); __builtin_amdgcn_s_setprio(0); } while (0)
#define PG8_WAIT_V(n) asm volatile("s_waitcnt vmcnt(" #n ")" ::: "memory")
#define PG8_WAIT_L(n) asm volatile("s_waitcnt lgkmcnt(" #n ")" ::: "memory")
#define PG8_BAR __builtin_amdgcn_s_barrier()
#define PG8_SCHED __builtin_amdgcn_sched_barrier(0)
    Unit cur, nxt; int ui = 0;
    if (!S.next(0, cur)) return;
    f32x4 acc[2][2][4][2];
#pragma unroll
    for (int a = 0; a < 2; ++a)
#pragma unroll
        for (int b = 0; b < 2; ++b)
#pragma unroll
            for (int m = 0; m < 4; ++m)
#pragma unroll
                for (int n = 0; n < 2; ++n) acc[a][b][m][n] = (f32x4){0.f, 0.f, 0.f, 0.f};
    bf16x8 At[4][2], B0[2][2], B1[2][2];
    const char* cA = (const char*)g.A + (size_t)cur.pb * g.sA * 2 + (size_t)cur.pm * tstepA; const char* cB = (const char*)g.Bt + (size_t)cur.pb * g.sB * 2 + (size_t)cur.pn * tstepB;
    S.a_ready(cur);
    if constexpr (SP2) {
        PG8_STAGE(PG8_SB(0, 0), cB, voffB); PG8_STAGE(PG8_SB(0, 1), cB + hstepB, voffB); PG8_STAGE(PG8_SA(0, 0), cA, voffA); PG8_STAGE(PG8_SA(0, 1), cA + hstepA, voffA);
        if (wr == 1) PG8_BAR;
        PG8_WAIT_V(2); PG8_BAR;
        PG8_STAGE(PG8_SB(1, 0), cB + kstep, voffB); PG8_STAGE(PG8_SA(1, 0), cA + kstepA, voffA); PG8_STAGE(PG8_SB(1, 1), cB + hstepB + kstep, voffB);
        PG8_WAIT_V(6); PG8_BAR;
    } else {
        PG8_STAGE(PG8_SB(0, 0), cB, voffB); PG8_STAGE(PG8_SA(0, 0), cA, voffA); PG8_STAGE(PG8_SB(0, 1), cB + hstepB, voffB); PG8_STAGE(PG8_SA(0, 1), cA + hstepA, voffA);
        if (wr == 1) PG8_BAR;
        PG8_WAIT_V(4); PG8_BAR;
        PG8_STAGE(PG8_SB(1, 0), cB + kstep, voffB); PG8_STAGE(PG8_SA(1, 0), cA + kstepA, voffA); PG8_STAGE(PG8_SB(1, 1), cB + hstepB + kstep, voffB);
        PG8_WAIT_V(6); PG8_BAR;
    }
    for (;;) {
        const bool has_next = S.next(ui + 1, nxt);
        const char* nA = has_next ? (const char*)g.A + (size_t)nxt.pb * g.sA * 2 + (size_t)nxt.pm * tstepA : cA; const char* nB = has_next ? (const char*)g.Bt + (size_t)nxt.pb * g.sB * 2 + (size_t)nxt.pn * tstepB : cB;
        for (int t = 0; t < nt; t += 2) {
            const bool last = (t == nt - 2);
            if constexpr (epi_midk_t<Epi>::value) { if (t == (nt >> 1)) E.midk(acc, cur, wr, wc, fr, fq); }
            const char* a1 = cA + (size_t)(t + 1) * kstepA;
            const char* a2 = last ? nA : cA + (size_t)(t + 2) * kstepA; const char* b2 = last ? nB : cB + (size_t)(t + 2) * kstep;
            const char* a3 = a2 + kstepA; const char* b3 = b2 + kstep;
            if (last && has_next) S.a_ready(nxt);
            if constexpr (SP2) {
            PG8_LDB(B0, 0, 0); PG8_LDB(B1, 0, 1); PG8_SCHED; PG8_LDA(At, 0, 0); PG8_STAGE(PG8_SA(1, 1), a1 + hstepA, voffA);
            PG8_WAIT_V(8); PG8_WAIT_L(0); PG8_BAR; PG8_MMA(0, 0, At, B0); PG8_MMA(0, 1, At, B1); PG8_BAR; PG8_SCHED;
            PG8_LDA(At, 0, 1); PG8_STAGE(PG8_SB(0, 0), b2, voffB); PG8_STAGE(PG8_SB(0, 1), b2 + hstepB, voffB); PG8_STAGE(PG8_SA(0, 0), a2, voffA);
            PG8_WAIT_V(8); PG8_WAIT_L(0); PG8_BAR; PG8_MMA(1, 0, At, B0); PG8_MMA(1, 1, At, B1); PG8_BAR; PG8_SCHED;
            PG8_LDB(B0, 1, 0); PG8_LDB(B1, 1, 1); PG8_SCHED; PG8_LDA(At, 1, 0); PG8_STAGE(PG8_SA(0, 1), a2 + hstepA, voffA);
            PG8_WAIT_V(8); PG8_WAIT_L(0); PG8_BAR; PG8_MMA(0, 0, At, B0); PG8_MMA(0, 1, At, B1); PG8_BAR; PG8_SCHED;
            PG8_LDA(At, 1, 1); PG8_STAGE(PG8_SB(1, 0), b3, voffB); PG8_STAGE(PG8_SB(1, 1), b3 + hstepB, voffB); PG8_STAGE(PG8_SA(1, 0), a3, voffA);
            PG8_WAIT_V(8); PG8_WAIT_L(0); PG8_BAR; PG8_MMA(1, 0, At, B0); PG8_MMA(1, 1, At, B1); PG8_BAR; PG8_SCHED;
            } else {
            PG8_LDB(B0, 0, 0); PG8_SCHED; PG8_LDA(At, 0, 0); PG8_STAGE(PG8_SA(1, 1), a1 + hstepA, voffA);
            PG8_WAIT_L(8); PG8_BAR; PG8_WAIT_L(0); PG8_MMA(0, 0, At, B0); PG8_BAR; PG8_SCHED;
            PG8_LDB(B1, 0, 1); PG8_STAGE(PG8_SB(0, 0), b2, voffB);
            PG8_BAR; PG8_WAIT_L(0); PG8_MMA(0, 1, At, B1); PG8_BAR;
            PG8_LDA(At, 0, 1); PG8_STAGE(PG8_SA(0, 0), a2, voffA);
            PG8_BAR; PG8_WAIT_L(0); PG8_MMA(1, 0, At, B0); PG8_BAR; PG8_SCHED;
            PG8_STAGE(PG8_SB(0, 1), b2 + hstepB, voffB);
            PG8_WAIT_V(6); PG8_BAR; PG8_MMA(1, 1, At, B1); PG8_BAR;
            PG8_LDB(B0, 1, 0); PG8_SCHED; PG8_LDA(At, 1, 0); PG8_STAGE(PG8_SA(0, 1), a2 + hstepA, voffA);
            PG8_WAIT_L(8); PG8_BAR; PG8_WAIT_L(0); PG8_MMA(0, 0, At, B0); PG8_BAR; PG8_SCHED;
            PG8_LDB(B1, 1, 1); PG8_STAGE(PG8_SB(1, 0), b3, voffB);
            PG8_BAR; PG8_WAIT_L(0); PG8_MMA(0, 1, At, B1); PG8_BAR;
            PG8_LDA(At, 1, 1); PG8_STAGE(PG8_SA(1, 0), a3, voffA);
            PG8_BAR; PG8_WAIT_L(0); PG8_MMA(1, 0, At, B0); PG8_BAR; PG8_SCHED;
            PG8_STAGE(PG8_SB(1, 1), b3 + hstepB, voffB);
            PG8_WAIT_V(6); PG8_BAR; PG8_MMA(1, 1, At, B1); PG8_BAR;
            }
        }
        if constexpr (ALIGN_EPI) { if (wr == 0) PG8_BAR; }
        if constexpr (!Epi::AFTER_DRAIN) { E(acc, cur, wr, wc, fr, fq); S.done(cur); }
        if (!has_next) break;
#pragma unroll
        for (int a = 0; a < 2; ++a)
#pragma unroll
            for (int b = 0; b < 2; ++b)
#pragma unroll
                for (int m = 0; m < 4; ++m)
#pragma unroll
                    for (int n = 0; n < 2; ++n) acc[a][b][m][n] = (f32x4){0.f, 0.f, 0.f, 0.f};
        cur = nxt; cA = nA; cB = nB; ++ui;
        if constexpr (ALIGN_EPI) { if (wr == 1) PG8_BAR; }
    }
    PG8_WAIT_V(0);
    if constexpr (!ALIGN_EPI) { if (wr == 0) PG8_BAR; }
    PG8_BAR;
    if constexpr (Epi::AFTER_DRAIN) { E.fused(acc, cur, wr, wc, fr, fq, lds, wid, lane); S.done(cur); }
#undef PG8_SA
#undef PG8_SB
#undef PG8_STAGE
#undef PG8_LDA
#undef PG8_LDB
#undef PG8_MMA
#undef PG8_WAIT_V
#undef PG8_WAIT_L
#undef PG8_BAR
#undef PG8_SCHED
}
}
#include <hip/hip_bf16.h>
#include <cmath>
namespace attn_body {
using bf16=__hip_bfloat16;
using bf16x8=__attribute__((ext_vector_type(8)))short;
using s16x4=__attribute__((ext_vector_type(4)))short;
using f32x16=__attribute__((ext_vector_type(16)))float;
using u32x4=__attribute__((ext_vector_type(4)))unsigned;
constexpr int BATCH=16,NHEAD=8,SEQ=2048,D=64,DM=NHEAD*D;
constexpr int NW=8,QBLK=32,QB=QBLK*NW,KVBLK=64,NQB=SEQ/QB;
constexpr int ATTN_PITCH=DM, ATTN_UNIT_ROWS=QB, ODM=1024;
__device__ __forceinline__ int crow(int r,int hi){return (r&3)+8*(r>>2)+4*hi;}
#define SBAR() __builtin_amdgcn_sched_barrier(0)
__device__ __forceinline__ void cmask(f32x16&p0,f32x16&p1,int jb,int qrel,int hi){
  const float NEG=-INFINITY; int kb=64*jb+4*hi;
  #pragma unroll
  for(int r=0;r<16;++r){int kv=kb+(r&3)+8*(r>>2); if(kv>qrel)p0[r]=NEG; if(kv+32>qrel)p1[r]=NEG;}
}

constexpr int NSLOT=3, SLOTB=8192;
constexpr int LDS_K=0, LDS_V=NSLOT*SLOTB, LDS_WS=2*NSLOT*SLOTB, LDS_OST=LDS_WS+NW*64*4, LDS_DK=LDS_OST+NW*4096, LDS_BYTES=LDS_DK+SEQ*4;
constexpr float C2=0.125f*1.4426950408889634f;
__device__ __forceinline__ void glds16(const void*gsrc,unsigned lds_dst){unsigned keep;
  asm volatile("s_mov_b32 %0, m0\n\ts_mov_b32 m0, %2\n\ts_nop 0\n\tglobal_load_lds_dwordx4 %1, off\n\ts_mov_b32 m0, %0":"=&s"(keep):"v"(gsrc),"s"(lds_dst):"memory");}
__device__ __forceinline__ float max3f(float a,float b,float c){float r;asm("v_max3_f32 %0, %1, %2, %3":"=v"(r):"v"(a),"v"(b),"v"(c));return r;}
__device__ __forceinline__ float max2f(float a,float b){float r;asm("v_max_f32_e32 %0, %1, %2":"=v"(r):"v"(a),"v"(b));return r;}
__device__ __forceinline__ float fadd_s(float a,float b){float r;asm("v_add_f32_e32 %0, %1, %2":"=v"(r):"v"(a),"v"(b));return r;}
__device__ __forceinline__ float fsub_s(float a,float b){float r;asm("v_sub_f32_e32 %0, %1, %2":"=v"(r):"v"(a),"v"(b));return r;}
typedef float f32x2_t __attribute__((ext_vector_type(2))); typedef __bf16 bf16x2_t __attribute__((ext_vector_type(2)));
__device__ __forceinline__ unsigned cvtpk_s(float lo,float hi){f32x2_t v={lo,hi};bf16x2_t b=__builtin_convertvector(v,bf16x2_t);return __builtin_bit_cast(unsigned,b);}
#define WAIT_BAR(N) asm volatile("s_waitcnt vmcnt(" #N ") lgkmcnt(0)\n\ts_barrier":::"memory")

__device__ __forceinline__ void qkt(f32x16&p0,f32x16&p1,const char*Kslot,const bf16x8*qr,const f32x16&negm,int r32,int hi){
  const char*kb=Kslot+hi*1024+r32*16;
  #pragma unroll
  for(int d0=0;d0<4;++d0){
    const bf16x8 b0=*reinterpret_cast<const bf16x8*>(kb+d0*2048);
    const bf16x8 b1=*reinterpret_cast<const bf16x8*>(kb+d0*2048+512);
    if(d0==0){p0=__builtin_amdgcn_mfma_f32_32x32x16_bf16(b0,qr[0],negm,0,0,0);p1=__builtin_amdgcn_mfma_f32_32x32x16_bf16(b1,qr[0],negm,0,0,0);}
    else{p0=__builtin_amdgcn_mfma_f32_32x32x16_bf16(b0,qr[d0],p0,0,0,0);p1=__builtin_amdgcn_mfma_f32_32x32x16_bf16(b1,qr[d0],p1,0,0,0);}}
}
typedef __attribute__((address_space(3))) const char* lds_cptr;
typedef short v4i16_t __attribute__((ext_vector_type(4)));
__device__ __forceinline__ void kload8(bf16x8*kf,lds_cptr kp){
  kf[0]=*(const __attribute__((address_space(3))) bf16x8*)(kp);      kf[1]=*(const __attribute__((address_space(3))) bf16x8*)(kp+512);
  kf[2]=*(const __attribute__((address_space(3))) bf16x8*)(kp+2048); kf[3]=*(const __attribute__((address_space(3))) bf16x8*)(kp+2560);
  kf[4]=*(const __attribute__((address_space(3))) bf16x8*)(kp+4096); kf[5]=*(const __attribute__((address_space(3))) bf16x8*)(kp+4608);
  kf[6]=*(const __attribute__((address_space(3))) bf16x8*)(kp+6144); kf[7]=*(const __attribute__((address_space(3))) bf16x8*)(kp+6656);
}
__device__ __forceinline__ void kload2(bf16x8*kf,lds_cptr kp,int j){ kf[2*j]=*(const __attribute__((address_space(3))) bf16x8*)(kp+j*2048); kf[2*j+1]=*(const __attribute__((address_space(3))) bf16x8*)(kp+j*2048+512); }
__device__ __forceinline__ s16x4 vtr(lds_cptr p){ return __builtin_bit_cast(s16x4,__builtin_amdgcn_ds_read_tr16_b64_v4i16((__attribute__((address_space(3))) v4i16_t*)p)); }
__device__ __forceinline__ float rowmax(const f32x16&p0,const f32x16&p1){
  float a=max3f(p0[0],p0[1],p1[0]),b=max3f(p0[2],p0[3],p1[1]);a=max3f(a,p1[2],p1[3]);
  #pragma unroll
  for(int r=4;r<16;r+=4){a=max3f(a,p0[r],p0[r+1]);b=max3f(b,p0[r+2],p0[r+3]);a=max3f(a,p1[r],p1[r+1]);b=max3f(b,p1[r+2],p1[r+3]);}
  const float m=max2f(a,b);
  auto rr=__builtin_amdgcn_permlane32_swap(__float_as_uint(m),__float_as_uint(m),false,false);
  return max2f(__uint_as_float(rr[0]),__uint_as_float(rr[1]));
}
__device__ __forceinline__ void pv(f32x16*o,int vb,bf16x8 pa0,bf16x8 pa1,bf16x8 pa2,bf16x8 pa3){
  #pragma unroll
  for(int d0=0;d0<2;++d0){s16x4 lo[4],hi[4];
    #pragma unroll
    for(int ks=0;ks<4;++ks){
      asm volatile("ds_read_b64_tr_b16 %0,%1 offset:%c2":"=&v"(lo[ks]):"v"(vb),"i"(d0*4096+ks*1024):"memory");
      asm volatile("ds_read_b64_tr_b16 %0,%1 offset:%c2":"=&v"(hi[ks]):"v"(vb),"i"(d0*4096+ks*1024+512):"memory");}
    asm volatile("s_waitcnt lgkmcnt(0)":::"memory");SBAR();
    #define PK(k) (bf16x8){lo[k][0],lo[k][1],lo[k][2],lo[k][3],hi[k][0],hi[k][1],hi[k][2],hi[k][3]}
    o[d0]=__builtin_amdgcn_mfma_f32_32x32x16_bf16(pa0,PK(0),o[d0],0,0,0);
    o[d0]=__builtin_amdgcn_mfma_f32_32x32x16_bf16(pa1,PK(1),o[d0],0,0,0);
    o[d0]=__builtin_amdgcn_mfma_f32_32x32x16_bf16(pa2,PK(2),o[d0],0,0,0);
    o[d0]=__builtin_amdgcn_mfma_f32_32x32x16_bf16(pa3,PK(3),o[d0],0,0,0);
    #undef PK
  }
}

#ifndef ATTN_STORE16
#define ATTN_STORE16(p,v) (*(u32x4*)(p)=(v))
#endif
typedef float f32x4v __attribute__((ext_vector_type(4)));
typedef const __attribute__((address_space(3))) float* lds_fptr;
template<int THRL> __device__ __forceinline__ void attn_unit(int b,int h,int qb,const bf16*Q,const bf16*__restrict__ K,const bf16*__restrict__ V,bf16*O,const float*__restrict__ DKg,float*__restrict__ SSB,char*shm,const int widx){
  const int tid=fresh_tid(widx),lane=tid&63,r32=lane&31,hi=lane>>5; const int wid=__builtin_amdgcn_readfirstlane(tid>>6);
  const long rowbase=(long)b*SEQ; const int q0=qb*QB;
  const bf16*Qw=Q+(rowbase+q0+wid*QBLK)*DM+h*D;
  const bf16*Kh=K+rowbase*DM+h*D,*Vh=V+rowbase*DM+h*D;
  const unsigned lds0=(unsigned)(uintptr_t)shm;
  float*wsf=(float*)(shm+LDS_WS)+wid*64;
  const bf16*ksrc=Kh+(long)lane*DM+wid*8;
  const bf16*vsrc=Vh+(long)(16*(wid&3)+(lane>>2))*DM+(wid>>2)*32+(lane&3)*8;
  const unsigned kdst=lds0+LDS_K+wid*1024, vdst=lds0+LDS_V+wid*1024;
  #define DMA_K(t,slot) glds16(ksrc+(long)(t)*KVBLK*DM,(unsigned)__builtin_amdgcn_readfirstlane(kdst+(slot)))
  #define DMA_V(t,slot) glds16(vsrc+(long)(t)*KVBLK*DM,(unsigned)__builtin_amdgcn_readfirstlane(vdst+(slot)))
  const int vb0=(int)(lds0+LDS_V)+((lane>>4)&1)*32+(lane&3)*8+(4*hi+((lane&15)>>2))*64;
  const char*Kbase=shm+LDS_K; bf16x8 kf[8];
  const lds_cptr shm3=(lds_cptr)shm; const lds_cptr kp0=shm3+LDS_K+hi*1024+r32*16; const lds_cptr vp0=shm3+LDS_V+((lane>>4)&1)*32+(lane&3)*8+(4*hi+((lane&15)>>2))*64;
  const int NT=(q0+QB)/KVBLK;
  const lds_fptr dkl=(lds_fptr)(shm3+LDS_DK);
  { if(4*tid<q0+QB){ const f32x4v dv=*(const f32x4v*)(DKg+4*tid); *(__attribute__((address_space(3))) f32x4v*)((__attribute__((address_space(3))) char*)shm+LDS_DK+16*tid)=dv; } }
  DMA_K(0,0);DMA_V(0,0);DMA_K(1,SLOTB);
  bf16x8 qr[4];
  #pragma unroll
  for(int d0=0;d0<4;++d0)qr[d0]=*reinterpret_cast<const bf16x8*>(&Qw[(long)r32*DM+d0*16+hi*8]);
  float mhat=0.f,l_reg=0.f;f32x16 o[2];o[0]=f32x16{};o[1]=f32x16{};f32x16 negm;
  const int qrel=wid*QBLK+r32;
  #define CMASK(P0,P1,t) do{int jb_=(t)-(NT-4); if(jb_>=0)cmask(P0,P1,jb_,qrel,hi);}while(0)
  #define ADDB(P0,P1,t) do{ const lds_fptr dq_=dkl+64*(t)+4*hi; \
    _Pragma("unroll") for(int j_=0;j_<4;++j_){ const f32x4v b0_=*(const __attribute__((address_space(3))) f32x4v*)(dq_+8*j_); const f32x4v b1_=*(const __attribute__((address_space(3))) f32x4v*)(dq_+32+8*j_); \
      P0[4*j_]+=b0_[0];P0[4*j_+1]+=b0_[1];P0[4*j_+2]+=b0_[2];P0[4*j_+3]+=b0_[3]; P1[4*j_]+=b1_[0];P1[4*j_+1]+=b1_[1];P1[4*j_+2]+=b1_[2];P1[4*j_+3]+=b1_[3]; } }while(0)
  bool resc=false;
  #define START(P0,P1) do{ resc=false; _Pragma("unroll") for(int r=0;r<16;++r)P0[r]=__builtin_amdgcn_exp2f(P0[r]); }while(0)
  #define RESC() do{ if(resc){ asm volatile("s_waitcnt lgkmcnt(0)":::"memory"); \
      _Pragma("unroll") for(int d_=0;d_<2;++d_) _Pragma("unroll") for(int r=0;r<16;++r)o[d_][r]*=wsf[crow(r,hi)]; } }while(0)
  f32x16 pA0,pA1,pB0,pB1;
  int sl_prev=0,sl_cur=0,sl_next=SLOTB;
  #define ROT() do{sl_prev=sl_cur;sl_cur=sl_next;sl_next=(sl_next==(NSLOT-1)*SLOTB)?0:sl_next+SLOTB;}while(0)
  DMA_K(2,2*SLOTB);
  WAIT_BAR(3);
  const float dkq=dkl[q0+qrel];
  mhat=dkq+16.0f;
  _Pragma("unroll") for(int r=0;r<16;++r)negm[r]=-mhat; asm volatile("":"+v"(negm));
  qkt(pA0,pA1,Kbase,qr,negm,r32,hi);asm volatile("s_nop 15\n\ts_nop 7":"+v"(pA0),"+v"(pA1));CMASK(pA0,pA1,0);ADDB(pA0,pA1,0);
  START(pA0,pA1);
  _Pragma("unroll") for(int r=0;r<16;++r)pA1[r]=__builtin_amdgcn_exp2f(pA1[r]);
  WAIT_BAR(0);
  DMA_K(3,0);DMA_V(1,SLOTB);
  ROT();
  kload8(kf,kp0+sl_cur);
  WAIT_BAR(2);
  s16x4 vlo[8],vhi[8]; u32x4 pw0,pw1,pw2,pw3;
  #define PKW(P,B) cvtpk_s(P[B],P[B+1])
  #define PAF(k) __builtin_bit_cast(bf16x8,pw##k)
  #define VFR(i) (bf16x8){vlo[i][0],vlo[i][1],vlo[i][2],vlo[i][3],vhi[i][0],vhi[i][1],vhi[i][2],vhi[i][3]}
  #define PIN(x) asm volatile("":"+v"(x))
  #define MX3(a,b,c) __builtin_fmaxf(__builtin_fmaxf((a),(b)),(c))
  #define GAPA(MF,A0,A1,A2,A3,W0,W1,PW) do{ MF; sacc+=A0; sacc+=A1; sacc+=A2; sacc+=A3; PIN(sacc); W0; W1; PIN(PW); SBAR(); }while(0)
  #define EX(v) __builtin_amdgcn_exp2f(v)
  #define GAPB(MF,X,B) do{ MF; X[B]=EX(X[B]); X[B+1]=EX(X[B+1]); X[B+2]=EX(X[B+2]); X[B+3]=EX(X[B+3]); PIN(X); SBAR(); }while(0)
  #define VRD(i) do{ vlo[i]=vtr(vp_+(((i)>>2)*4096+((i)&3)*1024)); vhi[i]=vtr(vp_+(((i)>>2)*4096+((i)&3)*1024+512)); }while(0)
  #define KRD(G,j) do{ if(G){ kload2(kf,kp0+sl_next,j); SBAR(); } }while(0)
  #define STEP(C0,C1,P0,P1,t,GK,GV,GL) do{ SBAR(); \
    const lds_cptr vp_=vp0+sl_prev; \
    VRD(0); SBAR(); float sacc=(P0[0]+P0[1]); \
    GAPA(C0=__builtin_amdgcn_mfma_f32_32x32x16_bf16(kf[0],qr[0],negm,0,0,0), P0[2],P0[3],P0[4],P0[5],     pw0[0]=PKW(P0,0), pw0[1]=PKW(P0,2), pw0); \
    VRD(4); SBAR(); GAPA(C1=__builtin_amdgcn_mfma_f32_32x32x16_bf16(kf[1],qr[0],negm,0,0,0), P0[6],P0[7],P0[8],P0[9],     pw0[2]=PKW(P0,4), pw0[3]=PKW(P0,6), pw0); \
    VRD(1); SBAR(); GAPA(C0=__builtin_amdgcn_mfma_f32_32x32x16_bf16(kf[2],qr[1],C0,0,0,0),   P0[10],P0[11],P0[12],P0[13], pw1[0]=PKW(P0,8), pw1[1]=PKW(P0,10), pw1); \
    VRD(5); SBAR(); GAPA(C1=__builtin_amdgcn_mfma_f32_32x32x16_bf16(kf[3],qr[1],C1,0,0,0),   P0[14],P0[15],P1[0],P1[1],   pw1[2]=PKW(P0,12),pw1[3]=PKW(P0,14), pw1); \
    VRD(2); SBAR(); GAPA(C0=__builtin_amdgcn_mfma_f32_32x32x16_bf16(kf[4],qr[2],C0,0,0,0),   P1[2],P1[3],P1[4],P1[5],     pw2[0]=PKW(P1,0), pw2[1]=PKW(P1,2), pw2); \
    VRD(6); SBAR(); GAPA(C1=__builtin_amdgcn_mfma_f32_32x32x16_bf16(kf[5],qr[2],C1,0,0,0),   P1[6],P1[7],P1[8],P1[9],     pw2[2]=PKW(P1,4), pw2[3]=PKW(P1,6), pw2); \
    VRD(3); SBAR(); GAPA(C0=__builtin_amdgcn_mfma_f32_32x32x16_bf16(kf[6],qr[3],C0,0,0,0),   P1[10],P1[11],P1[12],P1[13], pw3[0]=PKW(P1,8), pw3[1]=PKW(P1,10), pw3); \
    VRD(7); SBAR(); GAPA(C1=__builtin_amdgcn_mfma_f32_32x32x16_bf16(kf[7],qr[3],C1,0,0,0),   P1[14],P1[15],0.f,0.f,       pw3[2]=PKW(P1,12),pw3[3]=PKW(P1,14), pw3); \
    l_reg+=sacc; \
    if(GK){DMA_K((t)+3,sl_cur);} if(GV){DMA_V((t)+1,sl_next);} \
    CMASK(C0,C1,t); ADDB(C0,C1,t); \
      \
    SBAR(); \
    GAPB(o[0]=__builtin_amdgcn_mfma_f32_32x32x16_bf16(PAF(0),VFR(0),o[0],0,0,0), C0,0); \
    GAPB(o[1]=__builtin_amdgcn_mfma_f32_32x32x16_bf16(PAF(0),VFR(4),o[1],0,0,0), C0,4); \
    KRD(GL,0); GAPB(o[0]=__builtin_amdgcn_mfma_f32_32x32x16_bf16(PAF(1),VFR(1),o[0],0,0,0), C0,8); \
    KRD(GL,1); GAPB(o[1]=__builtin_amdgcn_mfma_f32_32x32x16_bf16(PAF(1),VFR(5),o[1],0,0,0), C0,12); \
    KRD(GL,2); GAPB(o[0]=__builtin_amdgcn_mfma_f32_32x32x16_bf16(PAF(2),VFR(2),o[0],0,0,0), C1,0); \
    KRD(GL,3); GAPB(o[1]=__builtin_amdgcn_mfma_f32_32x32x16_bf16(PAF(2),VFR(6),o[1],0,0,0), C1,4); \
    GAPB(o[0]=__builtin_amdgcn_mfma_f32_32x32x16_bf16(PAF(3),VFR(3),o[0],0,0,0), C1,8); \
    GAPB(o[1]=__builtin_amdgcn_mfma_f32_32x32x16_bf16(PAF(3),VFR(7),o[1],0,0,0), C1,12); \
    }while(0)
  int t=1;
  #undef CMASK
  #define CMASK(P0,P1,t) do{}while(0)
  for(;t+5<NT;t+=2){
    STEP(pB0,pB1,pA0,pA1,t,true,true,true);     WAIT_BAR(2); RESC(); ROT();
    STEP(pA0,pA1,pB0,pB1,t+1,true,true,true);   WAIT_BAR(2); RESC(); ROT();
  }
  #undef CMASK
  #define CMASK(P0,P1,t) do{int jb_=(t)-(NT-4); if(jb_>=0)cmask(P0,P1,jb_,qrel,hi);}while(0)
  #define ENDW(tt) do{ if((tt)+3<NT){WAIT_BAR(2);} else if((tt)+2<NT){WAIT_BAR(1);} else {WAIT_BAR(0);} }while(0)
  for(;t+1<NT;t+=2){
    STEP(pB0,pB1,pA0,pA1,t,(t+3<NT),(t+1<NT),(t+1<NT));       ENDW(t);   RESC(); ROT();
    STEP(pA0,pA1,pB0,pB1,t+1,(t+4<NT),(t+2<NT),(t+2<NT));     ENDW(t+1); RESC(); ROT();
  }
  STEP(pB0,pB1,pA0,pA1,NT-1,false,false,false); RESC();
  { float sacc=pB0[0]+pB0[1]; _Pragma("unroll") for(int r=2;r<16;++r)sacc+=pB0[r]; _Pragma("unroll") for(int r=0;r<16;++r)sacc+=pB1[r]; l_reg+=sacc;
    pw0=(u32x4){PKW(pB0,0),PKW(pB0,2),PKW(pB0,4),PKW(pB0,6)};pw1=(u32x4){PKW(pB0,8),PKW(pB0,10),PKW(pB0,12),PKW(pB0,14)};pw2=(u32x4){PKW(pB1,0),PKW(pB1,2),PKW(pB1,4),PKW(pB1,6)};pw3=(u32x4){PKW(pB1,8),PKW(pB1,10),PKW(pB1,12),PKW(pB1,14)};
    SBAR(); pv(o,vb0+sl_cur,PAF(0),PAF(1),PAF(2),PAF(3)); }
  #undef PKW
  #undef PAF
  #undef VFR
  #undef PIN
  #undef MX3
  #undef GAPA
  #undef GAPB
  #undef EX
  #undef VRD
  #undef KRD
  #undef STEP
  #undef ENDW
  {auto rr=__builtin_amdgcn_permlane32_swap(__float_as_uint(l_reg),__float_as_uint(l_reg),false,false);l_reg=__uint_as_float(rr[0])+__uint_as_float(rr[1]);}
  if(hi==0)wsf[32+r32]=l_reg;asm volatile("s_waitcnt lgkmcnt(0)":::"memory");
  float rli[16];
  #pragma unroll
  for(int r=0;r<16;++r)rli[r]=__builtin_amdgcn_rcpf(wsf[32+crow(r,hi)]);
  bf16*Ow=O+(rowbase+q0+wid*QBLK)*ODM+h*D;
  { bf16*stg=(bf16*)(shm+LDS_OST)+wid*2048;
    #pragma unroll
    for(int r=0;r<16;++r){const int orow=crow(r,hi);
      #pragma unroll
      for(int d0=0;d0<2;++d0)stg[orow*64+d0*32+r32]=__float2bfloat16(o[d0][r]*rli[r]);}
    asm volatile("s_waitcnt lgkmcnt(0)":::"memory");
    #pragma unroll
    for(int i=0;i<4;++i){const int row=i*8+(lane>>3),ch=lane&7; const u32x4 v=*(const u32x4*)(stg+row*64+ch*8); ATTN_STORE16(Ow+(long)row*ODM+ch*8,v);
      float s2=0.f; { const unsigned w4[4]={v.x,v.y,v.z,v.w};
        _Pragma("unroll") for(int e=0;e<4;++e){ const float lo=__uint_as_float(w4[e]<<16), hi=__uint_as_float(w4[e]&0xffff0000u); s2+=lo*lo+hi*hi; } }
      s2+=__int_as_float(__builtin_amdgcn_update_dpp(0,__float_as_int(s2),0xB1,0xF,0xF,true)); s2+=__int_as_float(__builtin_amdgcn_update_dpp(0,__float_as_int(s2),0x4E,0xF,0xF,true)); s2+=__int_as_float(__builtin_amdgcn_update_dpp(0,__float_as_int(s2),0x141,0xF,0xF,true));
      if(ch==0) SSB[(rowbase+q0+wid*QBLK+row)*8+h]=s2; } }
  asm volatile("s_waitcnt lgkmcnt(0)\n\ts_barrier":::"memory");
  #undef DMA_K
  #undef DMA_V
  #undef CMASK
  #undef ADDB
  #undef START
  #undef RESC
  #undef ROT
}
constexpr int ATTN_LDS_BYTES=LDS_BYTES;
struct AttnTensors { const bf16* Q; const bf16* K; const bf16* V; bf16* O; const float* DK; float* SSB; };
struct AttnUnit { int bh; int qb; };
struct StaticOrder {
  int vcu, G;
  __device__ __forceinline__ explicit StaticOrder(int grid,int v):vcu(v),G(grid){}
  __device__ __forceinline__ bool next(int i,AttnUnit&u)const{ const int pr=(i>>1)*G+vcu; if(pr>=BATCH*NHEAD*NQB/2)return false; const int s=pr&3; u.bh=pr>>2; u.qb=(i&1)?s:(NQB-1-s); return true; }
  __device__ __forceinline__ void a_ready(const AttnUnit&)const{}
  __device__ __forceinline__ void done(const AttnUnit&)const{}
};
template<class Sched,int THRL=40> __device__ __forceinline__ void attn_phase(char*lds,const AttnTensors&T,const Sched&S,const int widx){
  AttnUnit u;
  for(int i=0;S.next(i,u);++i){ S.a_ready(u); attn_unit<THRL>(u.bh/NHEAD,u.bh%NHEAD,u.qb,T.Q,T.K,T.V,T.O,T.DK+(long)u.bh*SEQ,T.SSB,lds,widx); S.done(u); }
}
#undef SBAR
#undef WAIT_BAR
}
namespace cg = cooperative_groups;
constexpr int NWAVES = 8;
constexpr int BATCH = 16, SEQ = 2048, DM = 1024, M = BATCH * SEQ;
constexpr int DSSM = 512, DATT = 512, NH = 8, NG = 32, NP = 64;
constexpr int DFF = 2752, DFF2 = 5504, NUP = 5632, KDN = 2816, DINP = 2056;
constexpr int NCH = M / 16;
constexpr int KCAT = 384;
constexpr int MH = M / 2;
constexpr float EPS = 1e-6f;
constexpr float LOG2E = 1.4426950408889634f;

constexpr size_t MiB = 1u << 20;
constexpr size_t WS_WIN = 0, WS_WGLU = 4 * MiB, WS_WOUT = 5 * MiB, WS_WUP = 7 * MiB, WS_WDN = 18 * MiB, WS_BSL = 24 * MiB, WS_BSS = 28 * MiB, WS_LS = 34 * MiB, WS_DK = 35 * MiB;
constexpr size_t WS_XN = 36 * MiB, WS_UCAT = 100 * MiB, WS_Q = 148 * MiB, WS_K = 180 * MiB, WS_V = 212 * MiB, WS_SLOC = 244 * MiB, WS_Y = 276 * MiB, WS_YS = 308 * MiB, WS_MIX = 340 * MiB;
constexpr size_t WS_A16 = 4 * MiB + 512 * 1024;
constexpr size_t WS_OB = 404 * MiB;
constexpr size_t WS_CTL = 4 * MiB + 640 * 1024;
constexpr size_t WS_UFF = 100 * MiB, WS_ACT = 276 * MiB, WS_END = 452 * MiB;
static_assert(WS_UFF + (size_t)MH * NUP * 2 <= WS_ACT && WS_ACT + (size_t)M * KDN * 2 <= WS_END && WS_WDN + (size_t)1024 * KDN * 2 <= WS_BSL && WS_WUP + (size_t)NUP * 1024 * 2 <= WS_WDN, "d_ws map");

constexpr int RING_BYTES = 131072, MISC_OFF = RING_BYTES + 320, LDS_BYTES = 147456;
#define LAS __attribute__((address_space(3)))
typedef unsigned short bf16;
typedef unsigned v4u __attribute__((ext_vector_type(4)));
typedef unsigned v2u __attribute__((ext_vector_type(2)));
typedef float f32x4 __attribute__((ext_vector_type(4)));
#define LDS_WAIT() asm volatile("s_waitcnt lgkmcnt(0)" ::: "memory")
__device__ __forceinline__ unsigned pk2(float lo, float hi) { return pg8::cvt_pk_bf16(lo, hi); }
template <int CTRL> __device__ __forceinline__ float dppf(float v) { return __int_as_float(__builtin_amdgcn_update_dpp(0, __float_as_int(v), CTRL, 0xF, 0xF, true)); }
__device__ __forceinline__ float wave_sum(float v) {
    v += dppf<0xB1>(v); v += dppf<0x4E>(v); v += dppf<0x141>(v); v += dppf<0x140>(v);
    const int i = __float_as_int(v);
    return (__int_as_float(__builtin_amdgcn_readlane(i, 0)) + __int_as_float(__builtin_amdgcn_readlane(i, 16))) + (__int_as_float(__builtin_amdgcn_readlane(i, 32)) + __int_as_float(__builtin_amdgcn_readlane(i, 48)));
}
#define XB_TMO      128
#define XB_XCNT(j)  (256  + 64 * (j))
#define XB_XSUB(j)  (1280 + 64 * (j))
#define XB_XGEN(j)  (2304 + 64 * (j))
#define XB_TOP      3328
#define XB_TOPGEN   3392
#define XCD_BAR_WORDS 3456
#define XB_SPIN_CAP (1u << 18)

__device__ __forceinline__ unsigned xb_ld(unsigned* p)              { return __hip_atomic_load(p, __ATOMIC_RELAXED, __HIP_MEMORY_SCOPE_AGENT); }
__device__ __forceinline__ unsigned xb_add(unsigned* p, unsigned v) { return __hip_atomic_fetch_add(p, v, __ATOMIC_RELAXED, __HIP_MEMORY_SCOPE_AGENT); }
__device__ __forceinline__ unsigned xb_xcc_id() { return (unsigned)__builtin_amdgcn_s_getreg((3 << 11) | 20) & 0xFu; }
#define XB_SPIN(cond, bar) do { unsigned _sp = 0; while (cond) { __builtin_amdgcn_s_sleep(1); \
    if ((++_sp & 255u) == 0u) { if (xb_ld(&(bar)[XB_TMO])) break; if (_sp > XB_SPIN_CAP) { atomicAdd(&(bar)[XB_TMO], 1u); break; } } } } while (0)

struct XcdBarrier {
    unsigned* bar; unsigned x;
    volatile LAS unsigned* st;
};

__device__ __forceinline__ XcdBarrier xcd_barrier_post(unsigned* bar, volatile LAS unsigned* st) {
    XcdBarrier b; b.bar = bar; b.x = xb_xcc_id(); b.st = st;
    if (threadIdx.x == 0) (void)xb_add(&bar[XB_XCNT(b.x)], 1u);
    return b;
}
__device__ __forceinline__ void xcd_barrier_complete(unsigned* bar, unsigned x, unsigned& nloc, unsigned& nx) {
    const unsigned G = gridDim.x * gridDim.y * gridDim.z;
    unsigned sum, cnt, mine, sp = 0u;
    for (;;) {
        sum = 0u; cnt = 0u; mine = 0u;
#pragma unroll
        for (unsigned j = 0; j < 16; ++j) { const unsigned c = xb_ld(&bar[XB_XCNT(j)]); sum += c; cnt += (c > 0u) ? 1u : 0u; mine = (j == x) ? c : mine; }
        if (sum == G) break;
        __builtin_amdgcn_s_sleep(1);
        if ((++sp & 255u) == 0u) { if (xb_ld(&bar[XB_TMO])) break; if (sp > XB_SPIN_CAP) { atomicAdd(&bar[XB_TMO], 1u); break; } }
    }
    nloc = mine > 0u ? mine : 1u; nx = cnt > 0u ? cnt : 1u;
}

__device__ __forceinline__ void xcd_barrier(const XcdBarrier& b) {
    asm volatile("s_waitcnt vmcnt(0)" ::: "memory");
    __syncthreads();
    if (threadIdx.x == 0) {
        unsigned* bar = b.bar;
        __builtin_amdgcn_s_waitcnt(0);
        unsigned nloc = b.st[0], nx = b.st[1];
        if (nloc == 0u) { xcd_barrier_complete(bar, b.x, nloc, nx); b.st[0] = nloc; b.st[1] = nx; }
        const unsigned old = xb_add(&bar[XB_XSUB(b.x)], 1u);
        const unsigned gen = old / nloc;
        if (old + 1u == (gen + 1u) * nloc) {
            __builtin_amdgcn_fence(__ATOMIC_RELEASE, "agent");
            asm volatile("s_waitcnt vmcnt(0)" ::: "memory");
            const unsigned og = xb_add(&bar[XB_TOP], 1u);
            const unsigned tg = og / nx;
            if (og + 1u == (tg + 1u) * nx) xb_add(&bar[XB_TOPGEN], 1u);
            else XB_SPIN(xb_ld(&bar[XB_TOPGEN]) == tg, bar);
            __builtin_amdgcn_fence(__ATOMIC_ACQUIRE, "agent");
            xb_add(&bar[XB_XGEN(b.x)], 1u);
            asm volatile("s_waitcnt vmcnt(0)" ::: "memory");
        } else {
            XB_SPIN(xb_ld(&bar[XB_XGEN(b.x)]) == gen, bar);
            __builtin_amdgcn_fence(__ATOMIC_ACQUIRE, "agent");
            asm volatile("s_waitcnt vmcnt(0)" ::: "memory");
        }
    }
    __syncthreads();
}

struct Args { const float* in[24]; float* out; unsigned char* ws; };
enum { I_X = 0, I_NMIX, I_WIN, I_BF, I_LRE, I_LIM, I_BRE, I_BIM, I_CRE, I_CIM, I_DSK, I_LDT, I_WGLU, I_BGLU, I_QN, I_KN, I_NOS, I_NOA, I_WOUT, I_NFFN, I_WUP, I_CW, I_CB, I_WDN };

__device__ __forceinline__ void p0_transpose_item(const float* W, int ldw, int nblk, bf16* WT, int ldo, LAS float* scr, int item, int lane, const bool permqk = false, const bool upmap = false, const float* gsc = nullptr) {
    const int kb = item / nblk, nb = item % nblk, k0 = 64 * kb, n0 = 32 * nb;
    const int d0 = upmap ? (n0 < 2752 ? ((n0 >> 7) * 256 + (n0 & 127)) : (((n0 - 2752) >> 7) * 256 + 128 + ((n0 - 2752) & 127))) : (permqk && n0 >= 512 && n0 < 1536) ? ((n0 & ~255) | (((n0 >> 5) & 1) << 7) | (((n0 >> 6) & 3) << 5)) : n0;
#pragma unroll
    for (int i = 0; i < 32; ++i) { const int kk = 2 * i + (lane >> 5); scr[kk * 33 + (lane & 31)] = W[(size_t)(k0 + kk) * ldw + n0 + (lane & 31)] * (gsc ? gsc[k0 + kk] : 1.f); }
    LDS_WAIT(); asm volatile("" ::: "memory");
    const int c = lane & 7;
#pragma unroll
    for (int j = 0; j < 4; ++j) { const int n = (lane >> 3) + 8 * j; const LAS float* s = scr + (8 * c) * 33 + n;
        v4u o; o.x = pk2(s[0 * 33], s[1 * 33]); o.y = pk2(s[2 * 33], s[3 * 33]); o.z = pk2(s[4 * 33], s[5 * 33]); o.w = pk2(s[6 * 33], s[7 * 33]);
        *(v4u*)(WT + (size_t)(d0 + n) * ldo + k0 + 8 * c) = o; }
    LDS_WAIT(); asm volatile("" ::: "memory");
}
struct Cplx { float re, im; };
__device__ __forceinline__ Cplx s5_apow(float lr, float li, float dt, int d) { const float mg = expf(lr * dt * (float)d), an = li * dt * (float)d; return Cplx{mg * cosf(an), mg * sinf(an)}; }
__device__ __forceinline__ Cplx s5_q(float lr, float li, float dt) {
    const float th = li * dt, sh = sinf(0.5f * th), em = expm1f(lr * dt); const float nr = em * cosf(th) - 2.f * sh * sh, ni = (em + 1.f) * sinf(th), den = lr * lr + li * li; return Cplx{(nr * lr + ni * li) / den, (ni * lr - nr * li) / den}; }


__device__ __forceinline__ void ssm_pair(LAS unsigned char* lds, const bf16* __restrict__ Uc, const bf16* __restrict__ Bsl, const bf16* __restrict__ Bss, const float* __restrict__ A16, bf16* __restrict__ Y, const int b, const int g, const int tid, const float* __restrict__ LSp, float* __restrict__ DKp, const int cbh, v4u (&uv)[8], const int nb, const int ng) {
    typedef short bf16x8v __attribute__((ext_vector_type(8)));
    const int lane = tid & 63, wave = __builtin_amdgcn_readfirstlane(tid >> 6), l15 = lane & 15, quad = lane >> 4;
    LAS unsigned char* const sU = lds; LAS unsigned char* const sS = lds + 65536;
    bf16x8v wb[8];
    { const bf16* wrow = Bsl + (size_t)g * 65536 + (size_t)(16 * wave + l15) * 256 + quad * 8;
#pragma unroll
      for (int ks = 0; ks < 8; ++ks) wb[ks] = *(const bf16x8v*)(wrow + ks * 32); }
    {
#pragma unroll
      for (int i = 0; i < 8; ++i) { const int idx = tid + 512 * i, row = idx >> 5, q = idx & 31; *(LAS v4u*)(sU + row * 512 + ((q ^ (row & 15)) << 4)) = uv[i]; } }
    __syncthreads();
    {
        f32x4 acc[8];
#pragma unroll
        for (int mt = 0; mt < 8; ++mt) acc[mt] = (f32x4){0.f, 0.f, 0.f, 0.f};
#pragma unroll
        for (int mt = 0; mt < 8; ++mt)
#pragma unroll
            for (int ks = 0; ks < 8; ++ks) { const bf16x8v a = *(const LAS bf16x8v*)(sU + (16 * mt + l15) * 512 + (((ks * 4 + quad) ^ l15) << 4));
                acc[mt] = __builtin_amdgcn_mfma_f32_16x16x32_bf16(a, wb[ks], acc[mt], 0, 0, 0); }
#pragma unroll
        for (int mt = 0; mt < 8; ++mt)
#pragma unroll
            for (int j = 0; j < 4; ++j) ((LAS float*)sS)[(16 * mt + quad * 4 + j) * 128 + 16 * wave + l15] = acc[mt][j];
    }
    bf16x8v yb[2][12];
#pragma unroll
    for (int n2 = 0; n2 < 2; ++n2) { const bf16* brow = Bss + (size_t)g * (256 * 384) + (size_t)(16 * (2 * wave + n2) + l15) * 384 + quad * 8;
#pragma unroll
        for (int ks = 0; ks < 12; ++ks) yb[n2][ks] = *(const bf16x8v*)(brow + ks * 32); }
    if (nb >= 0) { const v4u* src = (const v4u*)(Uc + ((size_t)ng * 2048 + (size_t)nb * 128) * 256);
#pragma unroll
        for (int i = 0; i < 8; ++i) uv[i] = src[tid + 512 * i]; }
    __syncthreads();
    if (wave == 0) {
        const int p = lane; const float ar = A16[(g * 64 + p) * 2], ai = A16[(g * 64 + p) * 2 + 1]; float xr = 0.f, xi = 0.f;
        for (int c0 = 0; c0 < 128; c0 += 8) { float sr[8], si[8];
#pragma unroll
            for (int j = 0; j < 8; ++j) { sr[j] = ((const LAS float*)sS)[(c0 + j) * 128 + p]; si[j] = ((const LAS float*)sS)[(c0 + j) * 128 + 64 + p]; }
            asm volatile("s_waitcnt lgkmcnt(0)" ::: "memory");
#pragma unroll
            for (int j = 0; j < 8; ++j) { const unsigned w = pk2(xr, xi); *(LAS bf16*)(sS + (c0 + j) * 512 + 2 * p) = (bf16)(w & 0xffffu); *(LAS bf16*)(sS + (c0 + j) * 512 + 128 + 2 * p) = (bf16)(w >> 16);
                const float nr = ar * xr - ai * xi + sr[j], ni = ar * xi + ai * xr + si[j]; xr = nr; xi = ni; }
            asm volatile("" ::: "memory"); }
    }
    if (wave == 1) {
        const int cb = cbh >> 3, ch = cbh & 7; const float* lsp = LSp + ((size_t)cb * 2048 + 32 * lane) * 8 + ch;
        float lv[32]; float loc = 0.f;
#pragma unroll
        for (int i = 0; i < 32; ++i) { lv[i] = lsp[i * 8]; }
#pragma unroll
        for (int i = 0; i < 32; ++i) loc += lv[i];
        float inc = loc;
#pragma unroll
        for (int o = 1; o < 64; o <<= 1) { const float t = __shfl_up(inc, o); if (lane >= o) inc += t; }
        float run = inc - loc; float* dk = DKp + (size_t)cbh * 2048 + 32 * lane;
#pragma unroll
        for (int i = 0; i < 32; i += 4) { f32x4 o4; run += lv[i]; o4[0] = -1.4426950408889634f * run; run += lv[i + 1]; o4[1] = -1.4426950408889634f * run; run += lv[i + 2]; o4[2] = -1.4426950408889634f * run; run += lv[i + 3]; o4[3] = -1.4426950408889634f * run; *(f32x4*)(dk + i) = o4; }
        asm volatile("s_waitcnt vmcnt(0)" ::: "memory");
    }
    __syncthreads();
    {
        f32x4 ya[2][8];
#pragma unroll
        for (int n2 = 0; n2 < 2; ++n2)
#pragma unroll
            for (int mt = 0; mt < 8; ++mt) ya[n2][mt] = (f32x4){0.f, 0.f, 0.f, 0.f};
#pragma unroll
        for (int mt = 0; mt < 8; ++mt)
#pragma unroll
            for (int ks = 0; ks < 12; ++ks) {
                const bf16x8v f = ks < 8 ? *(const LAS bf16x8v*)(sU + (16 * mt + l15) * 512 + (((ks * 4 + quad) ^ l15) << 4)) : *(const LAS bf16x8v*)(sS + (16 * mt + l15) * 512 + (((ks - 8) * 4 + quad) << 4));
                ya[0][mt] = __builtin_amdgcn_mfma_f32_16x16x32_bf16(yb[0][ks], f, ya[0][mt], 0, 0, 0);
                ya[1][mt] = __builtin_amdgcn_mfma_f32_16x16x32_bf16(yb[1][ks], f, ya[1][mt], 0, 0, 0); }
        __syncthreads();
#pragma unroll
        for (int n2 = 0; n2 < 2; ++n2)
#pragma unroll
            for (int mt = 0; mt < 8; ++mt) { const int tl = 16 * (16 * mt + l15) + 2 * wave + n2; const f32x4 v = ya[n2][mt];
                v2u w; w.x = pk2(pg8::gelu_tanh(v[0]), pg8::gelu_tanh(v[1])); w.y = pk2(pg8::gelu_tanh(v[2]), pg8::gelu_tanh(v[3]));
                *(LAS v2u*)(sU + tl * 32 + quad * 8) = w; }
        __syncthreads();
        { v4u* dst = (v4u*)(Y + ((size_t)g * 32768 + (size_t)b * 2048) * 16);
#pragma unroll
          for (int i = 0; i < 8; ++i) dst[tid + 512 * i] = *(const LAS v4u*)(sU + (tid + 512 * i) * 16); }
    }
    __syncthreads();
}

__global__ void __launch_bounds__(NWAVES * 64, 2) hymba_fwd(Args args) {
    extern __shared__ __attribute__((aligned(16))) unsigned char lds[];
    cg::grid_group grid = cg::this_grid();
    LAS unsigned char* const ldsp = (LAS unsigned char*)lds;
    const int widx = __builtin_amdgcn_readfirstlane((int)threadIdx.x >> 6);
    const int G = gridDim.x; const int bx = blockIdx.x; const int vcu = (G % 8 == 0) ? (bx % 8) * (G / 8) + bx / 8 : bx;
    const int NGW = G * NWAVES;
#define PHASE_IDS const int tid = fresh_tid(widx), lane = tid & 63, wave = __builtin_amdgcn_readfirstlane(tid >> 6), gw = vcu * NWAVES + wave; (void)lane; (void)gw
    unsigned char* const ws = args.ws;
    unsigned* const barw = (unsigned*)(ws + WS_CTL);
    { PHASE_IDS;
      for (int u = tid; u < (LDS_BYTES - RING_BYTES) / 4; u += NWAVES * 64) ((LAS unsigned*)(ldsp + RING_BYTES))[u] = 0u;
      __syncthreads(); }
    if (ws == nullptr) grid.sync();
    const XcdBarrier bar = xcd_barrier_post(barw, (volatile LAS unsigned*)(ldsp + MISC_OFF) + 8);
    const float* const x = args.in[I_X]; float* const out = args.out;
    bf16* const Win_t = (bf16*)(ws + WS_WIN); bf16* const Wglu_t = (bf16*)(ws + WS_WGLU); bf16* const Wout_t = (bf16*)(ws + WS_WOUT); bf16* const Wup_t = (bf16*)(ws + WS_WUP); bf16* const Wdn_t = (bf16*)(ws + WS_WDN);
    bf16* const Bsl = (bf16*)(ws + WS_BSL); bf16* const Bss = (bf16*)(ws + WS_BSS); float* const LS = (float*)(ws + WS_LS); float* const DK = (float*)(ws + WS_DK);
    bf16* const XN = (bf16*)(ws + WS_XN); bf16* const Ucat = (bf16*)(ws + WS_UCAT); bf16* const Qb = (bf16*)(ws + WS_Q); bf16* const Kb = (bf16*)(ws + WS_K); bf16* const Vb = (bf16*)(ws + WS_V);
    float* const Sloc = (float*)(ws + WS_SLOC); bf16* const Yb = (bf16*)(ws + WS_Y); bf16* const YS = (bf16*)(ws + WS_YS); bf16* const MIX = (bf16*)(ws + WS_MIX);
    float* const A16 = (float*)(ws + WS_A16); bf16* const OB = (bf16*)(ws + WS_OB);
    bf16* const RAWB = (bf16*)(ws + WS_UFF);
    bf16* const ACT = (bf16*)(ws + WS_ACT);
    float* const RS0 = (float*)(ws + WS_CTL + 65536 + 131072);
    float* const RS = (float*)(ws + WS_CTL + 65536);
    float* const SS = (float*)(ws + WS_YS);
    float* const RATIO = (float*)(ws + WS_YS + 2 * MiB); float* const RS2X = (float*)(ws + WS_YS + 2 * MiB + 256 * 1024);
    float* const SSB = (float*)(ws + WS_LS);
    float* const SSA = (float*)(ws + WS_DK);

    {
        PHASE_IDS;
        LAS float* scr = (LAS float*)(ldsp + wave * 16384);
        constexpr int I_IN = 16 * 64, I_GL = 8 * 16, I_OU = 16 * 32, I_UP = 16 * 172, I_DN = 43 * 32;
        constexpr int T_END = I_IN + I_GL + I_OU + I_UP + I_DN, Z_UP = 32, Z_DN = 16, S_A = NG * 16, S_B = NG * 16, S_C = NG * 16, S_D = NG;
        constexpr int NITEMS = T_END + Z_UP + Z_DN + S_A + S_B + S_C + S_D;
        for (int it = gw; it < NITEMS; it += NGW) {
            int r = it < 1536 ? it : (it < 2048 ? it + (5840 - 1536) : (it < 6352 ? it - 512 : it));
            if (r < I_IN) { p0_transpose_item(args.in[I_WIN], DINP, 64, Win_t, 1024, scr, r, lane, true); continue; } r -= I_IN;
            if (r < I_GL) { p0_transpose_item(args.in[I_WGLU], 512, 16, Wglu_t, 512, scr, r, lane); continue; } r -= I_GL;
            if (r < I_OU) { p0_transpose_item(args.in[I_WOUT], 1024, 32, Wout_t, 1024, scr, r, lane, false, false, (r / 32) < 8 ? args.in[I_NOS] : args.in[I_NOA] - 512); continue; }     r -= I_OU;
            if (r < I_UP) { p0_transpose_item(args.in[I_WUP], DFF2, 172, Wup_t, 1024, scr, r, lane, false, true, args.in[I_NFFN]); continue; } r -= I_UP;
            if (r < I_DN) { p0_transpose_item(args.in[I_WDN], 1024, 32, Wdn_t, KDN, scr, r, lane); continue; } r -= I_DN;
            if (r < Z_UP) {
                for (int i = lane; i < 512; i += 64) { const int idx = 4 * r + (i >> 7); const int row = 21 * 256 + (idx < 64 ? 64 + idx : 192 + (idx - 64)); *((v4u*)(Wup_t + (size_t)row * 1024) + (i & 127)) = (v4u){0u, 0u, 0u, 0u}; }
                continue; } r -= Z_UP;
            if (r < Z_DN) { for (int i = lane; i < 64 * 8; i += 64) { const int row = r * 64 + (i >> 3); *(v4u*)(Wdn_t + (size_t)row * KDN + DFF + 8 * (i & 7)) = (v4u){0u, 0u, 0u, 0u}; } continue; } r -= Z_DN;
            const int p = lane;
            if (r < S_A) {
                const int g = r >> 4, d = r & 15;
                const float dt = expf(args.in[I_LDT][g]), lr = args.in[I_LRE][g * 64 + p], li = args.in[I_LIM][g * 64 + p];
                const Cplx ad = s5_apow(lr, li, dt, d), q = s5_q(lr, li, dt);
#pragma unroll 4
                for (int h = 0; h < 16; ++h) { const float cr = args.in[I_CRE][(g * 16 + h) * 64 + p], ci = args.in[I_CIM][(g * 16 + h) * 64 + p];
                    scr[h * 64 + p] = (float)(cr * ad.re - ci * ad.im); scr[1024 + h * 64 + p] = (float)(cr * ad.im + ci * ad.re); }
#pragma unroll 4
                for (int h = 0; h < 16; ++h) { const float br = args.in[I_BRE][(g * 64 + p) * 16 + h], bi = args.in[I_BIM][(g * 64 + p) * 16 + h];
                    scr[2048 + p * 16 + h] = (float)(q.re * br - q.im * bi); scr[3072 + p * 16 + h] = (float)(q.re * bi + q.im * br); }
                LDS_WAIT(); asm volatile("" ::: "memory");
                const int h = lane >> 2, hp0 = 4 * (lane & 3); f32x4 acc = (f32x4){0.f, 0.f, 0.f, 0.f};
                for (int pp = 0; pp < 64; ++pp) { const float car = scr[h * 64 + pp], cai = scr[1024 + h * 64 + pp]; const f32x4 bbr = *(const LAS f32x4*)(scr + 2048 + pp * 16 + hp0), bbi = *(const LAS f32x4*)(scr + 3072 + pp * 16 + hp0);
                    acc += car * bbr - cai * bbi; }
                if (d == 0) { const float dsk = args.in[I_DSK][g * 16 + h];
#pragma unroll
                    for (int i = 0; i < 4; ++i) if (hp0 + i == h) acc[i] += dsk; }
                v2u w; w.x = pk2(acc[0], acc[1]); w.y = pk2(acc[2], acc[3]);
                bf16* Bg = Bss + (size_t)g * 256 * KCAT;
                for (int t = d; t < 16; ++t) *(v2u*)(Bg + (size_t)(t * 16 + h) * KCAT + (t - d) * 16 + hp0) = w;
                if (d > 0) for (int t = 0; t + d < 16; ++t) *(v2u*)(Bg + (size_t)(t * 16 + h) * KCAT + (t + d) * 16 + hp0) = (v2u){0u, 0u};
                LDS_WAIT(); asm volatile("" ::: "memory");
                continue; } r -= S_A;
            if (r < S_B) {
                const int g = r >> 4, t = r & 15;
                const float dt = expf(args.in[I_LDT][g]), lr = args.in[I_LRE][g * 64 + p], li = args.in[I_LIM][g * 64 + p];
                const Cplx a = s5_apow(lr, li, dt, t + 1);
                if (t == 15) { A16[(g * 64 + p) * 2] = (float)a.re; A16[(g * 64 + p) * 2 + 1] = (float)a.im; }
                bf16* Bg = Bss + (size_t)g * 256 * KCAT;
                for (int h = 0; h < 16; ++h) { const float cr = args.in[I_CRE][(g * 16 + h) * 64 + p], ci = args.in[I_CIM][(g * 16 + h) * 64 + p];
                    const unsigned w = pk2((float)(cr * a.re - ci * a.im), (float)(-(cr * a.im + ci * a.re)));
                    Bg[(size_t)(t * 16 + h) * KCAT + 256 + p] = (bf16)(w & 0xffffu); Bg[(size_t)(t * 16 + h) * KCAT + 320 + p] = (bf16)(w >> 16); }
                continue; } r -= S_B;
            if (r < S_C) {
                const int g = r >> 4, s = r & 15;
                const float dt = expf(args.in[I_LDT][g]), lr = args.in[I_LRE][g * 64 + p], li = args.in[I_LIM][g * 64 + p];
                const Cplx a = s5_apow(lr, li, dt, 15 - s), q = s5_q(lr, li, dt);
                bf16* Bg = Bsl + (size_t)g * 256 * 256;
                unsigned wr_[8], wi_[8];
#pragma unroll
                for (int h2 = 0; h2 < 8; ++h2) { float vr[2], vi[2];
#pragma unroll
                    for (int e = 0; e < 2; ++e) { const int h = 2 * h2 + e; const float br = args.in[I_BRE][(g * 64 + p) * 16 + h], bi = args.in[I_BIM][(g * 64 + p) * 16 + h];
                        const float bbr = q.re * br - q.im * bi, bbi = q.re * bi + q.im * br; vr[e] = (float)(a.re * bbr - a.im * bbi); vi[e] = (float)(a.re * bbi + a.im * bbr); }
                    wr_[h2] = pk2(vr[0], vr[1]); wi_[h2] = pk2(vi[0], vi[1]); }
                v4u* pr = (v4u*)(Bg + (size_t)p * 256 + s * 16); v4u* pi = (v4u*)(Bg + (size_t)(64 + p) * 256 + s * 16);
                pr[0] = (v4u){wr_[0], wr_[1], wr_[2], wr_[3]}; pr[1] = (v4u){wr_[4], wr_[5], wr_[6], wr_[7]};
                pi[0] = (v4u){wi_[0], wi_[1], wi_[2], wi_[3]}; pi[1] = (v4u){wi_[4], wi_[5], wi_[6], wi_[7]};
                continue; } r -= S_C;
            { v4u* pz = (v4u*)(Bsl + (size_t)r * 256 * 256 + 128 * 256);
              for (int i = lane; i < 4096; i += 64) pz[i] = (v4u){0u, 0u, 0u, 0u}; }
        }
        __syncthreads();
        LAS float* wfT = (LAS float*)ldsp;
        for (int i = tid; i < 8192; i += NWAVES * 64) { const int k = i >> 3, h = i & 7; wfT[h * 1024 + k] = args.in[I_WIN][(size_t)k * DINP + 2048 + h]; }
        __syncthreads();
        f32x4 gn[4];
#pragma unroll
        for (int j = 0; j < 4; ++j) gn[j] = *((const f32x4*)args.in[I_NMIX] + lane + 64 * j);
        const float bfg = args.in[I_BF][lane & 7];
        f32x4 nx[4];
        if (gw < M) {
#pragma unroll
            for (int j = 0; j < 4; ++j) nx[j] = ((const f32x4*)(x + (size_t)gw * DM) + lane)[64 * j];
        }
        for (int m = gw; m < M; m += NGW) {
            f32x4 v[4]; float s2 = 0.f;
#pragma unroll
            for (int j = 0; j < 4; ++j) v[j] = nx[j];
            if (m + NGW < M) {
#pragma unroll
                for (int j = 0; j < 4; ++j) nx[j] = ((const f32x4*)(x + (size_t)(m + NGW) * DM) + lane)[64 * j];
            }
#pragma unroll
            for (int j = 0; j < 4; ++j) s2 += (v[j].x * v[j].x + v[j].y * v[j].y) + (v[j].z * v[j].z + v[j].w * v[j].w);
            const float irs = sqrtf(wave_sum(s2) * (1.f / DM) + EPS), rs = 1.0f / irs; if (lane == 0) RS0[m] = irs;
            unsigned long long* o8 = (unsigned long long*)(XN + (size_t)m * DM) + lane;
#pragma unroll
            for (int j = 0; j < 4; ++j) { v[j] = v[j] * rs * gn[j]; o8[64 * j] = (unsigned long long)pk2(v[j].x, v[j].y) | ((unsigned long long)pk2(v[j].z, v[j].w) << 32); }
            float fl = 0.f;
#pragma unroll
            for (int h = 0; h < 8; ++h) { float a = 0.f;
#pragma unroll
                for (int j = 0; j < 4; ++j) { const f32x4 w = *(const LAS f32x4*)(wfT + h * 1024 + 256 * j + 4 * lane); a += (v[j].x * w.x + v[j].y * w.y) + (v[j].z * w.z + v[j].w * w.w); }
                a = wave_sum(a); if ((lane & 7) == h) fl = a; }
            if (lane < 8) { const float f = fl + bfg; LS[(size_t)m * 8 + lane] = fminf(f, 0.f) - log1pf(expf(-fabsf(f))); }
        }
    }
    xcd_barrier(bar);
    {
        pg8::Gemm g{XN, Win_t, 1024, 1024, 1024, 0, 0}; pg8::StaticOrder S; S.init(M, 2048, G, bx);
        pg8::EpiProj E{Ucat, Qb, Kb, Vb, args.in[I_QN], args.in[I_KN]};
        pg8::gemm_phase<pg8::EpiProj, pg8::StaticOrder, true, true>(ldsp, g, S, E, widx);
    }
    xcd_barrier(bar);
    { v4u uv[8];
      if (bx < BATCH * NG) { PHASE_IDS; const v4u* src = (const v4u*)(Ucat + ((size_t)(bx & 31) * 2048 + (size_t)(bx >> 5) * 128) * 256);
#pragma unroll
          for (int i = 0; i < 8; ++i) uv[i] = src[tid + 512 * i]; }
      int k = 0; for (int pi = bx; pi < BATCH * NG; pi += G, ++k) { PHASE_IDS; const int pn_ = pi + G; const bool hn_ = pn_ < BATCH * NG;
          ssm_pair(ldsp, Ucat, Bsl, Bss, A16, Yb, pi >> 5, pi & 31, tid, LS, DK, (k * G + vcu) >> 2, uv, hn_ ? (pn_ >> 5) : -1, pn_ & 31); } }
    {
        const attn_body::AttnTensors AT{(const attn_body::bf16*)Qb, (const attn_body::bf16*)Kb, (const attn_body::bf16*)Vb, (attn_body::bf16*)(MIX + 512), DK, SSB};
        const attn_body::StaticOrder S(G, vcu);
        attn_body::attn_phase<attn_body::StaticOrder>((char*)lds, AT, S, widx);
    }
    xcd_barrier(bar);
    {
        pg8::Gemm g{Yb, Wglu_t, 512, 512, 512, 0, 0, M}; pg8::StaticOrder S; S.init(M, 512, G, bx);
        pg8::EpiGlu E{Yb, MIX, args.in[I_BGLU], SSA};
        pg8::gemm_phase<pg8::EpiGlu, pg8::StaticOrder, true, true>(ldsp, g, S, E, widx);
    }
    xcd_barrier(bar);
    {
        pg8::Gemm g{MIX, Wout_t, 1024, 1024, 1024, 0, 0}; pg8::StaticOrder S; S.init(M, 1024, G, bx);
        {
            PHASE_IDS; pg8::Unit uu;
            for (int i = tid >> 8; S.next(i, uu); i += 2) { const int row = uu.pm * 256 + (tid & 255);
                const f32x4* pa = (const f32x4*)(SSA + (size_t)row * 8); const f32x4* pb = (const f32x4*)(SSB + (size_t)row * 8);
                const f32x4 a4 = pa[0] + pa[1], b4 = pb[0] + pb[1];
                const float r1 = 1.0f / sqrtf(((a4[0] + a4[1]) + (a4[2] + a4[3])) * (1.f / 512.f) + EPS), r2 = 1.0f / sqrtf(((b4[0] + b4[1]) + (b4[2] + b4[3])) * (1.f / 512.f) + EPS);
                RATIO[row] = r1 / r2; RS2X[row] = r2; }
            asm volatile("s_waitcnt vmcnt(0)" ::: "memory"); __syncthreads(); asm volatile("buffer_inv sc1" ::: "memory");
        }
        pg8::EpiResSq E{x, out, XN, SS, RATIO, RS2X, RS0, args.in[I_NMIX]};
        pg8::gemm_phase<pg8::EpiResSq, pg8::StaticOrder, true, true>(ldsp, g, S, E, widx);
    }
    xcd_barrier(bar);
    {
        PHASE_IDS;
        for (int row = vcu * (NWAVES * 64) + tid; row < M; row += G * NWAVES * 64) { const f32x4* sp = (const f32x4*)(SS + (size_t)row * 16); const f32x4 s4 = (sp[0] + sp[1]) + (sp[2] + sp[3]);
            RS[row] = 1.0f / sqrtf(((s4[0] + s4[1]) + (s4[2] + s4[3])) * (1.f / 1024.f) + EPS); }
    }
    xcd_barrier(bar);
    {
        pg8::Gemm g{XN, Wup_t, 1024, 1024, 1024, 0, 0}; pg8::StaticOrder S; S.init(M, NUP, G, bx);
        pg8::EpiUpConv E{ACT, RAWB, args.in[I_CW], args.in[I_CB], RS};
        pg8::gemm_phase<pg8::EpiUpConv, pg8::StaticOrder, true, true>(ldsp, g, S, E, widx);
    }
    xcd_barrier(bar);
    {
        PHASE_IDS;
        const float* cw = args.in[I_CW]; const float* cb = args.in[I_CB];
        const int gt = vcu * (NWAVES * 64) + tid, NT_ = G * NWAVES * 64;
        for (int it = gt; it < (M / 256) * 4 * 352; it += NT_) { const int cgp = it % 352, rest = it / 352, which = rest & 3, pm = rest >> 2;
            const int rho = (which & 1) + (which >> 1) * 128;
            bf16* ap = ACT + ((size_t)pm * 256 + rho) * KDN + 8 * cgp;
            if (cgp >= 344) { *(v4u*)ap = (v4u){0u, 0u, 0u, 0u}; continue; }
            const int j = 8 * cgp; const bool seq0 = (pm & 7) == 0;
            const int sx = which == 0 ? 0 : which == 1 ? 1 : which == 2 ? 4 : 5;
            const int s1 = which == 0 ? -1 : which == 1 ? 0 : which == 2 ? 3 : 4;
            const int s2 = which == 0 ? -2 : which == 1 ? -1 : which == 2 ? 2 : 3;
            const bool z1 = seq0 && s1 < 0, z2 = seq0 && s2 < 0;
            const bf16* rb = RAWB + (size_t)pm * 8 * NUP + j;
            const v4u zz = (v4u){0u, 0u, 0u, 0u};
            const v4u a0 = *(const v4u*)(rb + (ptrdiff_t)sx * NUP), c0 = *(const v4u*)(rb + (ptrdiff_t)sx * NUP + KDN);
            const v4u a1 = z1 ? zz : *(const v4u*)(rb + (ptrdiff_t)s1 * NUP), c1 = z1 ? zz : *(const v4u*)(rb + (ptrdiff_t)s1 * NUP + KDN);
            const v4u a2 = z2 ? zz : *(const v4u*)(rb + (ptrdiff_t)s2 * NUP), c2 = z2 ? zz : *(const v4u*)(rb + (ptrdiff_t)s2 * NUP + KDN);
            const float g0[8] = {pg8::bf_lo(a0.x), pg8::bf_hi(a0.x), pg8::bf_lo(a0.y), pg8::bf_hi(a0.y), pg8::bf_lo(a0.z), pg8::bf_hi(a0.z), pg8::bf_lo(a0.w), pg8::bf_hi(a0.w)};
            const float g1[8] = {pg8::bf_lo(a1.x), pg8::bf_hi(a1.x), pg8::bf_lo(a1.y), pg8::bf_hi(a1.y), pg8::bf_lo(a1.z), pg8::bf_hi(a1.z), pg8::bf_lo(a1.w), pg8::bf_hi(a1.w)};
            const float g2[8] = {pg8::bf_lo(a2.x), pg8::bf_hi(a2.x), pg8::bf_lo(a2.y), pg8::bf_hi(a2.y), pg8::bf_lo(a2.z), pg8::bf_hi(a2.z), pg8::bf_lo(a2.w), pg8::bf_hi(a2.w)};
            const float v0[8] = {pg8::bf_lo(c0.x), pg8::bf_hi(c0.x), pg8::bf_lo(c0.y), pg8::bf_hi(c0.y), pg8::bf_lo(c0.z), pg8::bf_hi(c0.z), pg8::bf_lo(c0.w), pg8::bf_hi(c0.w)};
            const float v1[8] = {pg8::bf_lo(c1.x), pg8::bf_hi(c1.x), pg8::bf_lo(c1.y), pg8::bf_hi(c1.y), pg8::bf_lo(c1.z), pg8::bf_hi(c1.z), pg8::bf_lo(c1.w), pg8::bf_hi(c1.w)};
            const float v2[8] = {pg8::bf_lo(c2.x), pg8::bf_hi(c2.x), pg8::bf_lo(c2.y), pg8::bf_hi(c2.y), pg8::bf_lo(c2.z), pg8::bf_hi(c2.z), pg8::bf_lo(c2.w), pg8::bf_hi(c2.w)};
            float o[8];
#pragma unroll
            for (int i = 0; i < 8; ++i) { const float cgt = cw[j + i] * g2[i] + cw[DFF2 + j + i] * g1[i] + cw[2 * DFF2 + j + i] * g0[i] + cb[j + i];
                const float cvl = cw[DFF + j + i] * v2[i] + cw[DFF2 + DFF + j + i] * v1[i] + cw[2 * DFF2 + DFF + j + i] * v0[i] + cb[DFF + j + i];
                o[i] = cgt * pg8::fast_sigmoid(cgt) * cvl; }
            v4u w; w.x = pk2(o[0], o[1]); w.y = pk2(o[2], o[3]); w.z = pk2(o[4], o[5]); w.w = pk2(o[6], o[7]);
            *(v4u*)ap = w; }
    }
    xcd_barrier(bar);
    {
        pg8::Gemm g{ACT, Wdn_t, KDN, KDN, KDN, 0, 0}; pg8::StaticOrder S; S.init(M, 1024, G, bx);
        pg8::EpiResB E{XN, out};
        pg8::gemm_phase<pg8::EpiResB, pg8::StaticOrder, true, false>(ldsp, g, S, E, widx);
    }
}

extern "C" void kernel_launch(void* const* d_in, const int* in_sizes, int n_in, void* d_out, int out_size, void* d_ws, size_t ws_size, hipStream_t stream) {
    static int grid = 0;
    if (grid == 0) {
        if (n_in != 24 || out_size != M * DM || ws_size < WS_END) { fprintf(stderr, "kernel_launch: unexpected problem (n_in %d, out %d, ws %zu); nothing launched\n", n_in, out_size, ws_size); grid = -1; return; }
        int dev = 0, cus = 0, per_cu = 0;
        if (hipGetDevice(&dev) != hipSuccess || hipDeviceGetAttribute(&cus, hipDeviceAttributeMultiprocessorCount, dev) != hipSuccess) { grid = -1; return; }
        if (hipFuncSetAttribute((const void*)hymba_fwd, hipFuncAttributeMaxDynamicSharedMemorySize, LDS_BYTES) != hipSuccess) { fprintf(stderr, "kernel_launch: hipFuncSetAttribute failed\n"); grid = -1; return; }
        if (hipOccupancyMaxActiveBlocksPerMultiprocessor(&per_cu, (const void*)hymba_fwd, NWAVES * 64, LDS_BYTES) != hipSuccess || per_cu < 1) { fprintf(stderr, "kernel_launch: occupancy query says %d blocks per CU\n", per_cu); per_cu = 1; }
        (void)hipGetLastError();
        if (cus != 256) { fprintf(stderr, "kernel_launch: built for a 256-CU device (got %d); nothing launched\n", cus); grid = -1; return; }
        grid = cus;
    }
    if (grid < 0) return;
    if (hipMemsetAsync((char*)d_ws + WS_CTL, 0, 16384, stream) != hipSuccess) { fprintf(stderr, "kernel_launch: hipMemsetAsync of the barrier words failed\n"); return; }
    Args a{};
    for (int i = 0; i < 24; ++i) a.in[i] = (const float*)d_in[i];
    a.out = (float*)d_out; a.ws = (unsigned char*)d_ws;
    void* kargs[] = {&a};
    const hipError_t e = hipLaunchCooperativeKernel((const void*)hymba_fwd, dim3(grid), dim3(NWAVES * 64), kargs, LDS_BYTES, stream);
    if (e != hipSuccess) fprintf(stderr, "kernel_launch: cooperative launch failed: %s (grid %d)\n", hipGetErrorString(e), grid);
}
```

```cpp
#include <hip/hip_runtime.h>
#include <hip/hip_cooperative_groups.h>
#include <cstdio>
#include <cstdint>
__device__ __forceinline__ int fresh_tid(int widx) { int l; asm volatile("v_mbcnt_lo_u32_b32 %0, -1, 0\n\tv_mbcnt_hi_u32_b32 %0, -1, %0" : "=v"(l)); return widx * 64 + l; }
namespace pg8 {
#define PG8_LAS __attribute__((address_space(3)))
typedef unsigned short bf16_t;
typedef short bf16x8 __attribute__((ext_vector_type(8)));
typedef float f32x4 __attribute__((ext_vector_type(4)));
typedef unsigned u32x4 __attribute__((ext_vector_type(4)));
constexpr int BM = 256, BK = 64, HALF = 128, HTB = HALF * BK * 2  , STAGE_BYTES = 8 * HTB, NXCD = 8, WGM = 4;

__host__ __device__ __forceinline__ int lds_byte(int r, int c) { const int st = (r >> 4) * 2 + (c >> 5), rr = r & 15, cc = c & 31, ob = rr * 64 + cc * 2; return st * 1024 + (ob ^ (((ob >> 9) & 1) << 5)); }
__host__ __device__ __forceinline__ void stage_rc(int b, int& R, int& C) { const int st = b / 1024, sb = b % 1024, swz = sb ^ (((sb >> 9) & 1) << 5); R = (st >> 1) * 16 + swz / 64; C = (st & 1) * 32 + (swz % 64) / 2; }
__host__ __device__ __forceinline__ int perm32(int rho) { const int n = rho >> 4, i = rho & 15; return 8 * (i >> 2) + 4 * n + (i & 3); }

struct Unit { int pm, pn, pb; };
struct Gemm { const bf16_t* A; const bf16_t* Bt; int K, lda, ldb; size_t sA, sB; int agm = 0; };

struct StaticOrder {
    int nM, nN, nwg, G, c;
    __host__ __device__ void init(int M, int N, int G_, int c_) { nM = M / BM; nN = N / BM; nwg = nM * nN; G = G_; c = c_; }
    __host__ __device__ bool next(int i, Unit& u) const {
        const long L = (long)i * G + c; if (L >= nwg) return false;
        int wgid = (int)L; { const int q = nwg / NXCD, r = nwg % NXCD, xcd = wgid % NXCD, off = wgid / NXCD; wgid = (xcd < r ? xcd * (q + 1) : r * (q + 1) + (xcd - r) * q) + off; }
        const int nig = WGM * nN, gid = wgid / nig, fm = gid * WGM, gsz = (nM - fm) < WGM ? (nM - fm) : WGM;
        u.pm = fm + ((wgid % nig) % gsz); u.pn = (wgid % nig) / gsz; u.pb = 0; return true;
    }
    __device__ __forceinline__ void a_ready(const Unit&) const {}
    __device__ __forceinline__ void done(const Unit&) const {}
};

__device__ __forceinline__ unsigned cvt_pk_bf16(float lo, float hi) { unsigned r; asm volatile("v_cvt_pk_bf16_f32 %0, %1, %2" : "=v"(r) : "v"(lo), "v"(hi)); return r; }
typedef float f32x2 __attribute__((ext_vector_type(2)));
__device__ __forceinline__ f32x2 gelu_pk(f32x2 v) {
    const f32x2 av = __builtin_elementwise_abs(v), d = av * 0.2316418882f + 1.0f;
    f32x2 t; t.x = __builtin_amdgcn_rcpf(d.x); t.y = __builtin_amdgcn_rcpf(d.y);
    f32x2 q = t * 0.5307027145f + (-0.7265760135f); q = q * t + 0.7107068705f; q = q * t + (-0.142248368f); q = q * t + 0.127414796f; q = q * t;
    const f32x2 s = (v * v) * (-0.72134752044f);
    f32x2 e; e.x = __builtin_amdgcn_exp2f(s.x); e.y = __builtin_amdgcn_exp2f(s.y);
    const f32x2 m = v * (q * e), r = v - m;
    f32x2 o; o.x = v.x < 0.f ? m.x : r.x; o.y = v.y < 0.f ? m.y : r.y; return o;
}

template <int ACT  > struct EpiBf16 {
    static constexpr bool PERM = true, AFTER_DRAIN = false; static_assert(ACT == 0 || ACT == 1, "EpiBf16: ACT is 0 (none) or 1 (gelu_pk)");
    bf16_t* O; int ldc; const float* bias; int split_cols; size_t split_stride; float scale0;
    __device__ __forceinline__ void operator()(const f32x4 (&acc)[2][2][4][2], const Unit& u, int wr, int wc, int fr, int fq) const {
        const int row0 = u.pm * BM + wr * 64 + fr; int colt = u.pn * BM; bf16_t* base = O;
        float sc = 1.f; if (split_cols) { const int t = colt / split_cols; base += (size_t)t * split_stride; colt -= t * split_cols; if (t == 0) sc = scale0; }
        const int col0 = colt + wc * 32 + 8 * fq, bcol0 = u.pn * BM + wc * 32 + 8 * fq;
        f32x4 bv[2][2];
#pragma unroll
        for (int bj = 0; bj < 2; ++bj)
#pragma unroll
            for (int n = 0; n < 2; ++n) bv[bj][n] = bias ? *(const f32x4*)(bias + bcol0 + bj * HALF + 4 * n) : (f32x4){0.f, 0.f, 0.f, 0.f};
#pragma unroll
        for (int ai = 0; ai < 2; ++ai)
#pragma unroll
            for (int m = 0; m < 4; ++m) { bf16_t* rowp = base + (size_t)(row0 + ai * HALF + m * 16) * ldc + col0;
#pragma unroll
                for (int bj = 0; bj < 2; ++bj) { f32x4 v0 = acc[ai][bj][m][0] + bv[bj][0], v1 = acc[ai][bj][m][1] + bv[bj][1];
                    if (ACT == 1) { f32x2 a = gelu_pk((f32x2){v0[0], v0[1]}), b = gelu_pk((f32x2){v0[2], v0[3]}), c = gelu_pk((f32x2){v1[0], v1[1]}), d = gelu_pk((f32x2){v1[2], v1[3]});
                        v0 = (f32x4){a.x, a.y, b.x, b.y}; v1 = (f32x4){c.x, c.y, d.x, d.y}; }
                    v0 = v0 * sc; v1 = v1 * sc; u32x4 w; w.x = cvt_pk_bf16(v0[0], v0[1]); w.y = cvt_pk_bf16(v0[2], v0[3]); w.z = cvt_pk_bf16(v1[0], v1[1]); w.w = cvt_pk_bf16(v1[2], v1[3]);
                    *(u32x4*)(rowp + bj * HALF) = w; } }
    }
};
__device__ __forceinline__ float fast_sigmoid(float z) { return __builtin_amdgcn_rcpf(1.0f + __builtin_amdgcn_exp2f(-1.4426950408889634f * z)); }
__device__ __forceinline__ float gelu_tanh(float v) { const float z = 1.5957691216057308f * (v + 0.044715f * v * v * v); return v * fast_sigmoid(z); }
__device__ __forceinline__ u32x4 pack8(const f32x4& a, const f32x4& b) { u32x4 w; w.x = cvt_pk_bf16(a[0], a[1]); w.y = cvt_pk_bf16(a[2], a[3]); w.z = cvt_pk_bf16(b[0], b[1]); w.w = cvt_pk_bf16(b[2], b[3]); return w; }
__device__ __forceinline__ float bf_lo(unsigned w) { return __uint_as_float(w << 16); }
__device__ __forceinline__ float bf_hi(unsigned w) { return __uint_as_float(w & 0xffff0000u); }

struct EpiProj { static constexpr bool PERM = true, AFTER_DRAIN = false;
    bf16_t* Ucat; bf16_t* Q; bf16_t* Kb; bf16_t* V; const float* qn; const float* kn;
    __device__ __forceinline__ void operator()(const f32x4 (&acc)[2][2][4][2], const Unit& u, int wr, int wc, int fr, int fq) const {
        const int row0 = u.pm * BM + wr * 64 + fr, sect = u.pn >> 1;
        if (sect == 1 || sect == 2) {
            const float* gp = (sect == 1 ? qn : kn) + 8 * fq; const float sc = sect == 1 ? 0.125f * 1.4426950408889634f : 1.f;
            const f32x4 g00 = *(const f32x4*)(gp), g01 = *(const f32x4*)(gp + 4), g10 = *(const f32x4*)(gp + 32), g11 = *(const f32x4*)(gp + 36);
            bf16_t* dst = Q + (size_t)(sect - 1) * ((size_t)32768 * 512) + (u.pn & 1) * 256 + 64 * wc + 8 * fq;
#pragma unroll
            for (int ai = 0; ai < 2; ++ai)
#pragma unroll
                for (int m = 0; m < 4; ++m) { const int row = row0 + ai * HALF + m * 16;
                    const f32x4 a0 = acc[ai][0][m][0], a1 = acc[ai][0][m][1], b0 = acc[ai][1][m][0], b1 = acc[ai][1][m][1];
                    float s = ((a0[0] * a0[0] + a0[1] * a0[1]) + (a0[2] * a0[2] + a0[3] * a0[3])) + ((a1[0] * a1[0] + a1[1] * a1[1]) + (a1[2] * a1[2] + a1[3] * a1[3]))
                            + ((b0[0] * b0[0] + b0[1] * b0[1]) + (b0[2] * b0[2] + b0[3] * b0[3])) + ((b1[0] * b1[0] + b1[1] * b1[1]) + (b1[2] * b1[2] + b1[3] * b1[3]));
                    s += __shfl_xor(s, 16); s += __shfl_xor(s, 32);
                    const float rs = sc / sqrtf(s * (1.f / 64.f) + 1e-6f);
                    *(u32x4*)(dst + (size_t)row * 512) = pack8(a0 * rs * g00, a1 * rs * g01);
                    *(u32x4*)(dst + (size_t)row * 512 + 32) = pack8(b0 * rs * g10, b1 * rs * g11); }
            return;
        }
        const int colb = (u.pn & 1) * 256 + wc * 32 + 8 * fq;
#pragma unroll
        for (int ai = 0; ai < 2; ++ai)
#pragma unroll
            for (int m = 0; m < 4; ++m) { const int row = row0 + ai * HALF + m * 16;
#pragma unroll
                for (int bj = 0; bj < 2; ++bj) { const int col = colb + bj * HALF; const u32x4 w = pack8(acc[ai][bj][m][0], acc[ai][bj][m][1]);
                    if (sect == 0) { const int g = col >> 4, hf = (col >> 3) & 1; *(u32x4*)(Ucat + ((size_t)(g * 2048 + (row >> 4)) * 256 + (row & 15) * 16 + hf * 8)) = w; }
                    else *(u32x4*)(V + (size_t)row * 512 + col) = w; } }
    }
};
struct EpiSloc { static constexpr bool PERM = false, AFTER_DRAIN = false;
    float* S;
    __device__ __forceinline__ void operator()(const f32x4 (&acc)[2][2][4][2], const Unit& u, int wr, int wc, int fr, int fq) const {
        const int row0 = u.pm * BM + wr * 64 + fr, col0 = wc * 32 + 4 * fq;
#pragma unroll
        for (int ai = 0; ai < 2; ++ai)
#pragma unroll
            for (int m = 0; m < 4; ++m) { float* rp = S + ((size_t)u.pb * 2048 + row0 + ai * HALF + m * 16) * 128 + col0;
#pragma unroll
                for (int n = 0; n < 2; ++n) *(f32x4*)(rp + 16 * n) = acc[ai][0][m][n]; }
    }
};
struct EpiSsm { static constexpr bool PERM = true, AFTER_DRAIN = false;
    bf16_t* Y;
    __device__ __forceinline__ void operator()(const f32x4 (&acc)[2][2][4][2], const Unit& u, int wr, int wc, int fr, int fq) const {
        const int row0 = u.pm * BM + wr * 64 + fr, colb = wc * 32 + 8 * fq;
#pragma unroll
        for (int ai = 0; ai < 2; ++ai)
#pragma unroll
            for (int m = 0; m < 4; ++m) { const int c = row0 + ai * HALF + m * 16;
#pragma unroll
                for (int bj = 0; bj < 2; ++bj) { const int col = colb + bj * HALF, t = col >> 4, h0 = col & 15;
                    f32x4 a = acc[ai][bj][m][0], b = acc[ai][bj][m][1];
#pragma unroll
                    for (int i = 0; i < 4; ++i) { a[i] = gelu_tanh(a[i]); b[i] = gelu_tanh(b[i]); }
                    *(u32x4*)(Y + (size_t)(16 * c + t) * 512 + 16 * u.pb + h0) = pack8(a, b); } }
    }
};
struct EpiGlu { static constexpr bool PERM = true, AFTER_DRAIN = false;
    const bf16_t* Y; bf16_t* O; const float* bias; float* ssa;
    __device__ __forceinline__ void operator()(const f32x4 (&acc)[2][2][4][2], const Unit& u, int wr, int wc, int fr, int fq) const {
        const int row0 = u.pm * BM + wr * 64 + fr, colb = u.pn * BM + wc * 32 + 8 * fq;
        f32x4 b0[2], b1[2];
#pragma unroll
        for (int bj = 0; bj < 2; ++bj) { b0[bj] = *(const f32x4*)(bias + colb + bj * HALF); b1[bj] = *(const f32x4*)(bias + colb + bj * HALF + 4); }
#pragma unroll
        for (int ai = 0; ai < 2; ++ai)
#pragma unroll
            for (int m = 0; m < 4; ++m) { const int row = row0 + ai * HALF + m * 16; float s = 0.f;
#pragma unroll
                for (int bj = 0; bj < 2; ++bj) { const int col = colb + bj * HALF; const u32x4 yv = *(const u32x4*)(Y + ((size_t)(col >> 4) * 32768 + row) * 16 + (col & 15));
                    f32x4 a = acc[ai][bj][m][0] + b0[bj], b = acc[ai][bj][m][1] + b1[bj];
                    a[0] = bf_lo(yv.x) * fast_sigmoid(a[0]); a[1] = bf_hi(yv.x) * fast_sigmoid(a[1]); a[2] = bf_lo(yv.y) * fast_sigmoid(a[2]); a[3] = bf_hi(yv.y) * fast_sigmoid(a[3]);
                    b[0] = bf_lo(yv.z) * fast_sigmoid(b[0]); b[1] = bf_hi(yv.z) * fast_sigmoid(b[1]); b[2] = bf_lo(yv.w) * fast_sigmoid(b[2]); b[3] = bf_hi(yv.w) * fast_sigmoid(b[3]);
                    s += ((a[0] * a[0] + a[1] * a[1]) + (a[2] * a[2] + a[3] * a[3])) + ((b[0] * b[0] + b[1] * b[1]) + (b[2] * b[2] + b[3] * b[3]));
                    *(u32x4*)(O + (size_t)row * 1024 + col) = pack8(a, b); }
                s += __shfl_xor(s, 16); s += __shfl_xor(s, 32);
                if (fq == 0) ssa[(size_t)row * 8 + u.pn * 4 + wc] = s; }
    }
};
struct EpiRes { static constexpr bool PERM = false, AFTER_DRAIN = false;
    const float* base; float* out;
    __device__ __forceinline__ void operator()(const f32x4 (&acc)[2][2][4][2], const Unit& u, int wr, int wc, int fr, int fq) const {
        const int row0 = u.pm * BM + wr * 64 + fr, col0 = u.pn * BM + wc * 32 + 4 * fq;
#pragma unroll
        for (int ai = 0; ai < 2; ++ai)
#pragma unroll
            for (int m = 0; m < 4; ++m) { const size_t off = (size_t)(row0 + ai * HALF + m * 16) * 1024 + col0;
#pragma unroll
                for (int bj = 0; bj < 2; ++bj)
#pragma unroll
                    for (int n = 0; n < 2; ++n) { const f32x4 bs = *(const f32x4*)(base + off + bj * HALF + n * 16); *(f32x4*)(out + off + bj * HALF + n * 16) = bs + acc[ai][bj][m][n]; } }
    }
};

template <int CTRL> __device__ __forceinline__ float dpp_f(float v) { return __int_as_float(__builtin_amdgcn_update_dpp(0, __float_as_int(v), CTRL, 0xF, 0xF, true)); }
__device__ __forceinline__ f32x4 sigmoid4(const f32x4 z) { f32x4 r; r[0] = fast_sigmoid(z[0]); r[1] = fast_sigmoid(z[1]); r[2] = fast_sigmoid(z[2]); r[3] = fast_sigmoid(z[3]); return r; }
struct EpiUpConv { static constexpr bool PERM = true, AFTER_DRAIN = false, ROWPERM = true;
    bf16_t* ACT; bf16_t* RAW; const float* cw; const float* cb; const float* ss;
    __device__ __forceinline__ void operator()(f32x4 (&acc)[2][2][4][2], const Unit& u, int wr, int wc, int fr, int fq) const {
        const int J0 = u.pn * 128 + wc * 32 + 8 * fq;
        const int tok0 = u.pm * BM + wr * 128 + fr * 8;
        {
            const f32x4 r0 = *(const f32x4*)(ss + tok0), r1 = *(const f32x4*)(ss + tok0 + 4);
#pragma unroll
            for (int m = 0; m < 4; ++m)
#pragma unroll
                for (int bj = 0; bj < 2; ++bj)
#pragma unroll
                    for (int n = 0; n < 2; ++n) { acc[0][bj][m][n] *= r0[m]; acc[1][bj][m][n] *= r1[m]; }
        }
        if (fr == 0) { bf16_t* rp = RAW + ((size_t)u.pm * 8 + wr * 4) * 5632 + J0;
            *(u32x4*)(rp) = pack8(acc[0][0][0][0], acc[0][0][0][1]); *(u32x4*)(rp + 2816) = pack8(acc[0][1][0][0], acc[0][1][0][1]);
            *(u32x4*)(rp + 5632) = pack8(acc[0][0][1][0], acc[0][0][1][1]); *(u32x4*)(rp + 5632 + 2816) = pack8(acc[0][1][1][0], acc[0][1][1][1]); }
        if (fr == 15) { bf16_t* rp = RAW + ((size_t)u.pm * 8 + wr * 4 + 2) * 5632 + J0;
            *(u32x4*)(rp) = pack8(acc[1][0][2][0], acc[1][0][2][1]); *(u32x4*)(rp + 2816) = pack8(acc[1][1][2][0], acc[1][1][2][1]);
            *(u32x4*)(rp + 5632) = pack8(acc[1][0][3][0], acc[1][0][3][1]); *(u32x4*)(rp + 5632 + 2816) = pack8(acc[1][1][3][0], acc[1][1][3][1]); }
#pragma unroll
        for (int n = 0; n < 2; ++n) {
            const int Jn = J0 + 4 * n; const bool ok = Jn < 2752; const f32x4 z4 = (f32x4){0.f, 0.f, 0.f, 0.f};
            const f32x4 w0g = ok ? *(const f32x4*)(cw + Jn) : z4, w1g = ok ? *(const f32x4*)(cw + 5504 + Jn) : z4, w2g = ok ? *(const f32x4*)(cw + 2 * 5504 + Jn) : z4, bg = ok ? *(const f32x4*)(cb + Jn) : z4;
            const f32x4 w0v = ok ? *(const f32x4*)(cw + 2752 + Jn) : z4, w1v = ok ? *(const f32x4*)(cw + 5504 + 2752 + Jn) : z4, w2v = ok ? *(const f32x4*)(cw + 2 * 5504 + 2752 + Jn) : z4, bv = ok ? *(const f32x4*)(cb + 2752 + Jn) : z4;
            f32x4 h2g, h1g, h2v, h1v;
#pragma unroll
            for (int i = 0; i < 4; ++i) { h2g[i] = dpp_f<0x111>(acc[1][0][2][n][i]); h1g[i] = dpp_f<0x111>(acc[1][0][3][n][i]); h2v[i] = dpp_f<0x111>(acc[1][1][2][n][i]); h1v[i] = dpp_f<0x111>(acc[1][1][3][n][i]); }
#pragma unroll
            for (int jj = 0; jj < 8; ++jj) { const int j = 7 - jj;
                const f32x4 g0 = acc[j >> 2][0][j & 3][n], v0 = acc[j >> 2][1][j & 3][n];
                const f32x4 g1 = j >= 1 ? acc[(j >= 1 ? j - 1 : 0) >> 2][0][(j >= 1 ? j - 1 : 0) & 3][n] : h1g, v1 = j >= 1 ? acc[(j >= 1 ? j - 1 : 0) >> 2][1][(j >= 1 ? j - 1 : 0) & 3][n] : h1v;
                const f32x4 g2 = j >= 2 ? acc[(j >= 2 ? j - 2 : 0) >> 2][0][(j >= 2 ? j - 2 : 0) & 3][n] : (j == 1 ? h1g : h2g), v2 = j >= 2 ? acc[(j >= 2 ? j - 2 : 0) >> 2][1][(j >= 2 ? j - 2 : 0) & 3][n] : (j == 1 ? h1v : h2v);
                const f32x4 og = w0g * g2 + w1g * g1 + w2g * g0 + bg, ov = w0v * v2 + w1v * v1 + w2v * v0 + bv;
                acc[j >> 2][0][j & 3][n] = og * sigmoid4(og) * ov; }
        }
#pragma unroll
        for (int ai = 0; ai < 2; ++ai)
#pragma unroll
            for (int m = 0; m < 4; ++m) *(u32x4*)(ACT + (size_t)(tok0 + 4 * ai + m) * 2816 + J0) = pack8(acc[ai][0][m][0], acc[ai][0][m][1]);
    }
};

struct EpiResSq { static constexpr bool PERM = true, AFTER_DRAIN = false, MIDK = true;
    const float* base; float* out; bf16_t* hb; float* ss; const float* ratio; const float* rs2; const float* irs0; const float* gmix;
    __device__ __forceinline__ void midk(f32x4 (&acc)[2][2][4][2], const Unit& u, int wr, int wc, int fr, int fq) const {
        const int row0 = u.pm * BM + wr * 64 + fr;
#pragma unroll
        for (int ai = 0; ai < 2; ++ai)
#pragma unroll
            for (int m = 0; m < 4; ++m) { const float r = ratio[row0 + ai * HALF + m * 16];
#pragma unroll
                for (int bj = 0; bj < 2; ++bj)
#pragma unroll
                    for (int n = 0; n < 2; ++n) acc[ai][bj][m][n] *= r; }
    }
    __device__ __forceinline__ void operator()(const f32x4 (&acc)[2][2][4][2], const Unit& u, int wr, int wc, int fr, int fq) const {
        const int row0 = u.pm * BM + wr * 64 + fr, col0 = u.pn * BM + wc * 32 + 8 * fq;
        f32x4 gi[2][2];
#pragma unroll
        for (int bj = 0; bj < 2; ++bj)
#pragma unroll
            for (int n = 0; n < 2; ++n) { const f32x4 gv = *(const f32x4*)(gmix + col0 + bj * HALF + 4 * n); gi[bj][n] = (f32x4){__builtin_amdgcn_rcpf(gv[0]), __builtin_amdgcn_rcpf(gv[1]), __builtin_amdgcn_rcpf(gv[2]), __builtin_amdgcn_rcpf(gv[3])}; }
#pragma unroll
        for (int ai = 0; ai < 2; ++ai)
#pragma unroll
            for (int m = 0; m < 4; ++m) { const int row = row0 + ai * HALF + m * 16; const size_t off = (size_t)row * 1024 + col0; float s = 0.f; const float r2 = rs2[row], ir = irs0[row];
#pragma unroll
                for (int bj = 0; bj < 2; ++bj) { const u32x4 xv = *(const u32x4*)(hb + off + bj * HALF);
                    const f32x4 x0 = (f32x4){bf_lo(xv.x), bf_hi(xv.x), bf_lo(xv.y), bf_hi(xv.y)} * gi[bj][0] * ir, x1 = (f32x4){bf_lo(xv.z), bf_hi(xv.z), bf_lo(xv.w), bf_hi(xv.w)} * gi[bj][1] * ir;
                    const f32x4 h0 = x0 + acc[ai][bj][m][0] * r2, h1 = x1 + acc[ai][bj][m][1] * r2;
                    s += ((h0[0] * h0[0] + h0[1] * h0[1]) + (h0[2] * h0[2] + h0[3] * h0[3])) + ((h1[0] * h1[0] + h1[1] * h1[1]) + (h1[2] * h1[2] + h1[3] * h1[3]));
                    *(u32x4*)(hb + off + bj * HALF) = pack8(h0, h1); }
                s += __shfl_xor(s, 16); s += __shfl_xor(s, 32);
                if (fq == 0) ss[(size_t)row * 16 + u.pn * 4 + wc] = s; }
    }
};

struct EpiResB { static constexpr bool PERM = false, AFTER_DRAIN = false;
    const bf16_t* base; float* out;
    __device__ __forceinline__ void operator()(const f32x4 (&acc)[2][2][4][2], const Unit& u, int wr, int wc, int fr, int fq) const {
        typedef unsigned u32x2 __attribute__((ext_vector_type(2)));
        const int row0 = u.pm * BM + wr * 64 + fr, col0 = u.pn * BM + wc * 32 + 4 * fq;
#pragma unroll
        for (int ai = 0; ai < 2; ++ai)
#pragma unroll
            for (int m = 0; m < 4; ++m) { const size_t off = (size_t)(row0 + ai * HALF + m * 16) * 1024 + col0;
#pragma unroll
                for (int bj = 0; bj < 2; ++bj)
#pragma unroll
                    for (int n = 0; n < 2; ++n) { const u32x2 w = *(const u32x2*)(base + off + bj * HALF + n * 16); const f32x4 bs = (f32x4){bf_lo(w.x), bf_hi(w.x), bf_lo(w.y), bf_hi(w.y)};
                        *(f32x4*)(out + off + bj * HALF + n * 16) = bs + acc[ai][bj][m][n]; } }
    }
};
struct BatchOrder {
    int nM, total, G, c;
    __host__ __device__ void init(int nB, int nM_, int G_, int c_) { nM = nM_; total = nB * nM_; G = G_; c = c_; }
    __host__ __device__ bool next(int i, Unit& u) const { const int L = i * G + c; if (L >= total) return false; u.pb = L / nM; u.pm = L % nM; u.pn = 0; return true; }
    __device__ __forceinline__ void a_ready(const Unit&) const {}
    __device__ __forceinline__ void done(const Unit&) const {}
};
struct OneUnit { int pb, pm;
    __host__ __device__ bool next(int i, Unit& u) const { if (i) return false; u.pb = pb; u.pm = pm; u.pn = 0; return true; }
    __device__ __forceinline__ void a_ready(const Unit&) const {}
    __device__ __forceinline__ void done(const Unit&) const {}
};
template <class Epi, class = void> struct epi_rowperm_t { static constexpr bool value = false; };
template <class Epi> struct epi_rowperm_t<Epi, decltype((void)Epi::ROWPERM)> { static constexpr bool value = Epi::ROWPERM; };
template <class Epi> __host__ __device__ constexpr bool epi_rowperm() { return epi_rowperm_t<Epi>::value; }
template <class Epi, class = void> struct epi_midk_t { static constexpr bool value = false; };
template <class Epi> struct epi_midk_t<Epi, decltype((void)Epi::MIDK)> { static constexpr bool value = Epi::MIDK; };
template <class Epi, class Sched, bool ALIGN_EPI = false, bool SP2 = false>
__device__ __forceinline__ void gemm_phase(PG8_LAS unsigned char* lds, const Gemm g, const Sched& S, const Epi& E, const int widx) {
    const int tid = fresh_tid(widx), wid = __builtin_amdgcn_readfirstlane(tid >> 6), lane = tid & 63, wr = wid >> 2, wc = wid & 3, fr = lane & 15, fq = lane >> 4;
    const int K = g.K, nt = K / BK;
    unsigned voffA[2], voffB[2];
#pragma unroll
    for (int i = 0; i < 2; ++i) { int R, C; stage_rc(tid * 16 + i * 8192, R, C); const int Rb = Epi::PERM ? ((R & ~31) + perm32(R & 31)) : R;
        voffA[i] = g.agm ? (unsigned)(((C >> 4) * g.agm + R) * 16 + (C & 15)) * 2u : (unsigned)((epi_rowperm<Epi>() ? (128 * (R >> 6) + 8 * (R & 15) + ((R >> 4) & 3)) : R) * g.lda + C) * 2u; voffB[i] = (unsigned)(Rb * g.ldb + C) * 2u; }
    const size_t kstep = (size_t)(BK * 2);
    const size_t kstepA = g.agm ? (size_t)4 * g.agm * 32 : kstep;
    const size_t hstepA = g.agm ? (size_t)HALF * 32 : (size_t)(epi_rowperm<Epi>() ? 4 : HALF) * g.lda * 2, hstepB = (size_t)HALF * g.ldb * 2;
    const size_t tstepA = g.agm ? (size_t)BM * 32 : (size_t)BM * g.lda * 2, tstepB = 2 * hstepB;
    const unsigned ldsw = (unsigned)wid * 1024u;
    const int aoff = lds_byte(wr * 64 + fr, fq * 8), boff = lds_byte(wc * 32 + fr, fq * 8);
#define PG8_SA(b, h) (((b) * 2 + (h)) * HTB)
#define PG8_SB(b, h) ((4 + (b) * 2 + (h)) * HTB)
#define PG8_STAGE(bufoff, gbase, voff) do { _Pragma("unroll") for (int _i = 0; _i < 2; ++_i) \
        __builtin_amdgcn_global_load_lds((const unsigned*)((const char*)(gbase) + (voff)[_i]), (PG8_LAS unsigned*)(lds + (bufoff) + ldsw + _i * 8192), 16, 0, 0); } while (0)
#define PG8_LDA(dst, b, h) do { _Pragma("unroll") for (int m = 0; m < 4; ++m) _Pragma("unroll") for (int k = 0; k < 2; ++k) dst[m][k] = *(const PG8_LAS bf16x8*)(lds + PG8_SA(b, h) + aoff + m * 2048 + k * 1024); } while (0)
#define PG8_LDB(dst, b, h) do { _Pragma("unroll") for (int n = 0; n < 2; ++n) _Pragma("unroll") for (int k = 0; k < 2; ++k) dst[n][k] = *(const PG8_LAS bf16x8*)(lds + PG8_SB(b, h) + boff + n * 2048 + k * 1024); } while (0)
#define PG8_MMA(ai, bj, At, Bt) do { __builtin_amdgcn_s_setprio(1); _Pragma("unroll") for (int m = 0; m < 4; ++m) _Pragma("unroll") for (int n = 0; n < 2; ++n) _Pragma("unroll") for (int k = 0; k < 2; ++k) \
        acc[ai][bj][m][n] = __builtin_amdgcn_mfma_f32_16x16x32_bf16(Bt[n][k], At[m][k], acc[ai][bj][m][n], 0, 0, 0); __builtin_amdgcn_s_setprio(0); } while (0)
#define PG8_WAIT_V(n) asm volatile("s_waitcnt vmcnt(" #n ")" ::: "memory")
#define PG8_WAIT_L(n) asm volatile("s_waitcnt lgkmcnt(" #n ")" ::: "memory")
#define PG8_BAR __builtin_amdgcn_s_barrier()
#define PG8_SCHED __builtin_amdgcn_sched_barrier(0)
    Unit cur, nxt; int ui = 0;
    if (!S.next(0, cur)) return;
    f32x4 acc[2][2][4][2];
#pragma unroll
    for (int a = 0; a < 2; ++a)
#pragma unroll
        for (int b = 0; b < 2; ++b)
#pragma unroll
            for (int m = 0; m < 4; ++m)
#pragma unroll
                for (int n = 0; n < 2; ++n) acc[a][b][m][n] = (f32x4){0.f, 0.f, 0.f, 0.f};
    bf16x8 At[4][2], B0[2][2], B1[2][2];
    const char* cA = (const char*)g.A + (size_t)cur.pb * g.sA * 2 + (size_t)cur.pm * tstepA; const char* cB = (const char*)g.Bt + (size_t)cur.pb * g.sB * 2 + (size_t)cur.pn * tstepB;
    S.a_ready(cur);
    if constexpr (SP2) {
        PG8_STAGE(PG8_SB(0, 0), cB, voffB); PG8_STAGE(PG8_SB(0, 1), cB + hstepB, voffB); PG8_STAGE(PG8_SA(0, 0), cA, voffA); PG8_STAGE(PG8_SA(0, 1), cA + hstepA, voffA);
        if (wr == 1) PG8_BAR;
        PG8_WAIT_V(2); PG8_BAR;
        PG8_STAGE(PG8_SB(1, 0), cB + kstep, voffB); PG8_STAGE(PG8_SA(1, 0), cA + kstepA, voffA); PG8_STAGE(PG8_SB(1, 1), cB + hstepB + kstep, voffB);
        PG8_WAIT_V(6); PG8_BAR;
    } else {
        PG8_STAGE(PG8_SB(0, 0), cB, voffB); PG8_STAGE(PG8_SA(0, 0), cA, voffA); PG8_STAGE(PG8_SB(0, 1), cB + hstepB, voffB); PG8_STAGE(PG8_SA(0, 1), cA + hstepA, voffA);
        if (wr == 1) PG8_BAR;
        PG8_WAIT_V(4); PG8_BAR;
        PG8_STAGE(PG8_SB(1, 0), cB + kstep, voffB); PG8_STAGE(PG8_SA(1, 0), cA + kstepA, voffA); PG8_STAGE(PG8_SB(1, 1), cB + hstepB + kstep, voffB);
        PG8_WAIT_V(6); PG8_BAR;
    }
    for (;;) {
        const bool has_next = S.next(ui + 1, nxt);
        const char* nA = has_next ? (const char*)g.A + (size_t)nxt.pb * g.sA * 2 + (size_t)nxt.pm * tstepA : cA; const char* nB = has_next ? (const char*)g.Bt + (size_t)nxt.pb * g.sB * 2 + (size_t)nxt.pn * tstepB : cB;
        for (int t = 0; t < nt; t += 2) {
            const bool last = (t == nt - 2);
            if constexpr (epi_midk_t<Epi>::value) { if (t == (nt >> 1)) E.midk(acc, cur, wr, wc, fr, fq); }
            const char* a1 = cA + (size_t)(t + 1) * kstepA;
            const char* a2 = last ? nA : cA + (size_t)(t + 2) * kstepA; const char* b2 = last ? nB : cB + (size_t)(t + 2) * kstep;
            const char* a3 = a2 + kstepA; const char* b3 = b2 + kstep;
            if (last && has_next) S.a_ready(nxt);
            if constexpr (SP2) {
            PG8_LDB(B0, 0, 0); PG8_LDB(B1, 0, 1); PG8_SCHED; PG8_LDA(At, 0, 0); PG8_STAGE(PG8_SA(1, 1), a1 + hstepA, voffA);
            PG8_WAIT_V(8); PG8_WAIT_L(0); PG8_BAR; PG8_MMA(0, 0, At, B0); PG8_MMA(0, 1, At, B1); PG8_BAR; PG8_SCHED;
            PG8_LDA(At, 0, 1); PG8_STAGE(PG8_SB(0, 0), b2, voffB); PG8_STAGE(PG8_SB(0, 1), b2 + hstepB, voffB); PG8_STAGE(PG8_SA(0, 0), a2, voffA);
            PG8_WAIT_V(8); PG8_WAIT_L(0); PG8_BAR; PG8_MMA(1, 0, At, B0); PG8_MMA(1, 1, At, B1); PG8_BAR; PG8_SCHED;
            PG8_LDB(B0, 1, 0); PG8_LDB(B1, 1, 1); PG8_SCHED; PG8_LDA(At, 1, 0); PG8_STAGE(PG8_SA(0, 1), a2 + hstepA, voffA);
            PG8_WAIT_V(8); PG8_WAIT_L(0); PG8_BAR; PG8_MMA(0, 0, At, B0); PG8_MMA(0, 1, At, B1); PG8_BAR; PG8_SCHED;
            PG8_LDA(At, 1, 1); PG8_STAGE(PG8_SB(1, 0), b3, voffB); PG8_STAGE(PG8_SB(1, 1), b3 + hstepB, voffB); PG8_STAGE(PG8_SA(1, 0), a3, voffA);
            PG8_WAIT_V(8); PG8_WAIT_L(0); PG8_BAR; PG8_MMA(1, 0, At, B0); PG8_MMA(1, 1, At, B1); PG8_BAR; PG8_SCHED;
            } else {
            PG8_LDB(B0, 0, 0); PG8_SCHED; PG8_LDA(At, 0, 0); PG8_STAGE(PG8_SA(1, 1), a1 + hstepA, voffA);
            PG8_WAIT_L(8); PG8_BAR; PG8_WAIT_L(0); PG8_MMA(0, 0, At, B0); PG8_BAR; PG8_SCHED;
            PG8_LDB(B1, 0, 1); PG8_STAGE(PG8_SB(0, 0), b2, voffB);
            PG8_BAR; PG8_WAIT_L(0); PG8_MMA(0, 1, At, B1); PG8_BAR;
            PG8_LDA(At, 0, 1); PG8_STAGE(PG8_SA(0, 0), a2, voffA);
            PG8_BAR; PG8_WAIT_L(0); PG8_MMA(1, 0, At, B0); PG8_BAR; PG8_SCHED;
            PG8_STAGE(PG8_SB(0, 1), b2 + hstepB, voffB);
            PG8_WAIT_V(6); PG8_BAR; PG8_MMA(1, 1, At, B1); PG8_BAR;
            PG8_LDB(B0, 1, 0); PG8_SCHED; PG8_LDA(At, 1, 0); PG8_STAGE(PG8_SA(0, 1), a2 + hstepA, voffA);
            PG8_WAIT_L(8); PG8_BAR; PG8_WAIT_L(0); PG8_MMA(0, 0, At, B0); PG8_BAR; PG8_SCHED;
            PG8_LDB(B1, 1, 1); PG8_STAGE(PG8_SB(1, 0), b3, voffB);
            PG8_BAR; PG8_WAIT_L(0); PG8_MMA(0, 1, At, B1); PG8_BAR;
            PG8_LDA(At, 1, 1); PG8_STAGE(PG8_SA(1, 0), a3, voffA);
            PG8_BAR; PG8_WAIT_L(0); PG8_MMA(1, 0, At, B0); PG8_BAR; PG8_SCHED;
            PG8_STAGE(PG8_SB(1, 1), b3 + hstepB, voffB);
            PG8_WAIT_V(6); PG8_BAR; PG8_MMA(1, 1, At, B1); PG8_BAR;
            }
        }
        if constexpr (ALIGN_EPI) { if (wr == 0) PG8_BAR; }
        if constexpr (!Epi::AFTER_DRAIN) { E(acc, cur, wr, wc, fr, fq); S.done(cur); }
        if (!has_next) break;
#pragma unroll
        for (int a = 0; a < 2; ++a)
#pragma unroll
            for (int b = 0; b < 2; ++b)
#pragma unroll
                for (int m = 0; m < 4; ++m)
#pragma unroll
                    for (int n = 0; n < 2; ++n) acc[a][b][m][n] = (f32x4){0.f, 0.f, 0.f, 0.f};
        cur = nxt; cA = nA; cB = nB; ++ui;
        if constexpr (ALIGN_EPI) { if (wr == 1) PG8_BAR; }
    }
    PG8_WAIT_V(0);
    if constexpr (!ALIGN_EPI) { if (wr == 0) PG8_BAR; }
    PG8_BAR;
    if constexpr (Epi::AFTER_DRAIN) { E.fused(acc, cur, wr, wc, fr, fq, lds, wid, lane); S.done(cur); }
#undef PG8_SA
#undef PG8_SB
#undef PG8_STAGE
#undef PG8_LDA
#undef PG8_LDB
#undef PG8_MMA
#undef PG8_WAIT_V
#undef PG8_WAIT_L
#undef PG8_BAR
#undef PG8_SCHED
}
}
#include <hip/hip_bf16.h>
#include <cmath>
namespace attn_body {
using bf16=__hip_bfloat16;
using bf16x8=__attribute__((ext_vector_type(8)))short;
using s16x4=__attribute__((ext_vector_type(4)))short;
using f32x16=__attribute__((ext_vector_type(16)))float;
using u32x4=__attribute__((ext_vector_type(4)))unsigned;
constexpr int BATCH=16,NHEAD=8,SEQ=2048,D=64,DM=NHEAD*D;
constexpr int NW=8,QBLK=32,QB=QBLK*NW,KVBLK=64,NQB=SEQ/QB;
constexpr int ATTN_PITCH=DM, ATTN_UNIT_ROWS=QB, ODM=1024;
__device__ __forceinline__ int crow(int r,int hi){return (r&3)+8*(r>>2)+4*hi;}
#define SBAR() __builtin_amdgcn_sched_barrier(0)
__device__ __forceinline__ void cmask(f32x16&p0,f32x16&p1,int jb,int qrel,int hi){
  const float NEG=-INFINITY; int kb=64*jb+4*hi;
  #pragma unroll
  for(int r=0;r<16;++r){int kv=kb+(r&3)+8*(r>>2); if(kv>qrel)p0[r]=NEG; if(kv+32>qrel)p1[r]=NEG;}
}

constexpr int NSLOT=3, SLOTB=8192;
constexpr int LDS_K=0, LDS_V=NSLOT*SLOTB, LDS_WS=2*NSLOT*SLOTB, LDS_OST=LDS_WS+NW*64*4, LDS_DK=LDS_OST+NW*4096, LDS_BYTES=LDS_DK+SEQ*4;
constexpr float C2=0.125f*1.4426950408889634f;
__device__ __forceinline__ void glds16(const void*gsrc,unsigned lds_dst){unsigned keep;
  asm volatile("s_mov_b32 %0, m0\n\ts_mov_b32 m0, %2\n\ts_nop 0\n\tglobal_load_lds_dwordx4 %1, off\n\ts_mov_b32 m0, %0":"=&s"(keep):"v"(gsrc),"s"(lds_dst):"memory");}
__device__ __forceinline__ float max3f(float a,float b,float c){float r;asm("v_max3_f32 %0, %1, %2, %3":"=v"(r):"v"(a),"v"(b),"v"(c));return r;}
__device__ __forceinline__ float max2f(float a,float b){float r;asm("v_max_f32_e32 %0, %1, %2":"=v"(r):"v"(a),"v"(b));return r;}
__device__ __forceinline__ float fadd_s(float a,float b){float r;asm("v_add_f32_e32 %0, %1, %2":"=v"(r):"v"(a),"v"(b));return r;}
__device__ __forceinline__ float fsub_s(float a,float b){float r;asm("v_sub_f32_e32 %0, %1, %2":"=v"(r):"v"(a),"v"(b));return r;}
typedef float f32x2_t __attribute__((ext_vector_type(2))); typedef __bf16 bf16x2_t __attribute__((ext_vector_type(2)));
__device__ __forceinline__ unsigned cvtpk_s(float lo,float hi){f32x2_t v={lo,hi};bf16x2_t b=__builtin_convertvector(v,bf16x2_t);return __builtin_bit_cast(unsigned,b);}
#define WAIT_BAR(N) asm volatile("s_waitcnt vmcnt(" #N ") lgkmcnt(0)\n\ts_barrier":::"memory")

__device__ __forceinline__ void qkt(f32x16&p0,f32x16&p1,const char*Kslot,const bf16x8*qr,const f32x16&negm,int r32,int hi){
  const char*kb=Kslot+hi*1024+r32*16;
  #pragma unroll
  for(int d0=0;d0<4;++d0){
    const bf16x8 b0=*reinterpret_cast<const bf16x8*>(kb+d0*2048);
    const bf16x8 b1=*reinterpret_cast<const bf16x8*>(kb+d0*2048+512);
    if(d0==0){p0=__builtin_amdgcn_mfma_f32_32x32x16_bf16(b0,qr[0],negm,0,0,0);p1=__builtin_amdgcn_mfma_f32_32x32x16_bf16(b1,qr[0],negm,0,0,0);}
    else{p0=__builtin_amdgcn_mfma_f32_32x32x16_bf16(b0,qr[d0],p0,0,0,0);p1=__builtin_amdgcn_mfma_f32_32x32x16_bf16(b1,qr[d0],p1,0,0,0);}}
}
typedef __attribute__((address_space(3))) const char* lds_cptr;
typedef short v4i16_t __attribute__((ext_vector_type(4)));
__device__ __forceinline__ void kload8(bf16x8*kf,lds_cptr kp){
  kf[0]=*(const __attribute__((address_space(3))) bf16x8*)(kp);      kf[1]=*(const __attribute__((address_space(3))) bf16x8*)(kp+512);
  kf[2]=*(const __attribute__((address_space(3))) bf16x8*)(kp+2048); kf[3]=*(const __attribute__((address_space(3))) bf16x8*)(kp+2560);
  kf[4]=*(const __attribute__((address_space(3))) bf16x8*)(kp+4096); kf[5]=*(const __attribute__((address_space(3))) bf16x8*)(kp+4608);
  kf[6]=*(const __attribute__((address_space(3))) bf16x8*)(kp+6144); kf[7]=*(const __attribute__((address_space(3))) bf16x8*)(kp+6656);
}
__device__ __forceinline__ void kload2(bf16x8*kf,lds_cptr kp,int j){ kf[2*j]=*(const __attribute__((address_space(3))) bf16x8*)(kp+j*2048); kf[2*j+1]=*(const __attribute__((address_space(3))) bf16x8*)(kp+j*2048+512); }
__device__ __forceinline__ s16x4 vtr(lds_cptr p){ return __builtin_bit_cast(s16x4,__builtin_amdgcn_ds_read_tr16_b64_v4i16((__attribute__((address_space(3))) v4i16_t*)p)); }
__device__ __forceinline__ float rowmax(const f32x16&p0,const f32x16&p1){
  float a=max3f(p0[0],p0[1],p1[0]),b=max3f(p0[2],p0[3],p1[1]);a=max3f(a,p1[2],p1[3]);
  #pragma unroll
  for(int r=4;r<16;r+=4){a=max3f(a,p0[r],p0[r+1]);b=max3f(b,p0[r+2],p0[r+3]);a=max3f(a,p1[r],p1[r+1]);b=max3f(b,p1[r+2],p1[r+3]);}
  const float m=max2f(a,b);
  auto rr=__builtin_amdgcn_permlane32_swap(__float_as_uint(m),__float_as_uint(m),false,false);
  return max2f(__uint_as_float(rr[0]),__uint_as_float(rr[1]));
}
__device__ __forceinline__ void pv(f32x16*o,int vb,bf16x8 pa0,bf16x8 pa1,bf16x8 pa2,bf16x8 pa3){
  #pragma unroll
  for(int d0=0;d0<2;++d0){s16x4 lo[4],hi[4];
    #pragma unroll
    for(int ks=0;ks<4;++ks){
      asm volatile("ds_read_b64_tr_b16 %0,%1 offset:%c2":"=&v"(lo[ks]):"v"(vb),"i"(d0*4096+ks*1024):"memory");
      asm volatile("ds_read_b64_tr_b16 %0,%1 offset:%c2":"=&v"(hi[ks]):"v"(vb),"i"(d0*4096+ks*1024+512):"memory");}
    asm volatile("s_waitcnt lgkmcnt(0)":::"memory");SBAR();
    #define PK(k) (bf16x8){lo[k][0],lo[k][1],lo[k][2],lo[k][3],hi[k][0],hi[k][1],hi[k][2],hi[k][3]}
    o[d0]=__builtin_amdgcn_mfma_f32_32x32x16_bf16(pa0,PK(0),o[d0],0,0,0);
    o[d0]=__builtin_amdgcn_mfma_f32_32x32x16_bf16(pa1,PK(1),o[d0],0,0,0);
    o[d0]=__builtin_amdgcn_mfma_f32_32x32x16_bf16(pa2,PK(2),o[d0],0,0,0);
    o[d0]=__builtin_amdgcn_mfma_f32_32x32x16_bf16(pa3,PK(3),o[d0],0,0,0);
    #undef PK
  }
}

#ifndef ATTN_STORE16
#define ATTN_STORE16(p,v) (*(u32x4*)(p)=(v))
#endif
typedef float f32x4v __attribute__((ext_vector_type(4)));
typedef const __attribute__((address_space(3))) float* lds_fptr;
template<int THRL> __device__ __forceinline__ void attn_unit(int b,int h,int qb,const bf16*Q,const bf16*__restrict__ K,const bf16*__restrict__ V,bf16*O,const float*__restrict__ DKg,float*__restrict__ SSB,char*shm,const int widx){
  const int tid=fresh_tid(widx),lane=tid&63,r32=lane&31,hi=lane>>5; const int wid=__builtin_amdgcn_readfirstlane(tid>>6);
  const long rowbase=(long)b*SEQ; const int q0=qb*QB;
  const bf16*Qw=Q+(rowbase+q0+wid*QBLK)*DM+h*D;
  const bf16*Kh=K+rowbase*DM+h*D,*Vh=V+rowbase*DM+h*D;
  const unsigned lds0=(unsigned)(uintptr_t)shm;
  float*wsf=(float*)(shm+LDS_WS)+wid*64;
  const bf16*ksrc=Kh+(long)lane*DM+wid*8;
  const bf16*vsrc=Vh+(long)(16*(wid&3)+(lane>>2))*DM+(wid>>2)*32+(lane&3)*8;
  const unsigned kdst=lds0+LDS_K+wid*1024, vdst=lds0+LDS_V+wid*1024;
  #define DMA_K(t,slot) glds16(ksrc+(long)(t)*KVBLK*DM,(unsigned)__builtin_amdgcn_readfirstlane(kdst+(slot)))
  #define DMA_V(t,slot) glds16(vsrc+(long)(t)*KVBLK*DM,(unsigned)__builtin_amdgcn_readfirstlane(vdst+(slot)))
  const int vb0=(int)(lds0+LDS_V)+((lane>>4)&1)*32+(lane&3)*8+(4*hi+((lane&15)>>2))*64;
  const char*Kbase=shm+LDS_K; bf16x8 kf[8];
  const lds_cptr shm3=(lds_cptr)shm; const lds_cptr kp0=shm3+LDS_K+hi*1024+r32*16; const lds_cptr vp0=shm3+LDS_V+((lane>>4)&1)*32+(lane&3)*8+(4*hi+((lane&15)>>2))*64;
  const int NT=(q0+QB)/KVBLK;
  const lds_fptr dkl=(lds_fptr)(shm3+LDS_DK);
  { if(4*tid<q0+QB){ const f32x4v dv=*(const f32x4v*)(DKg+4*tid); *(__attribute__((address_space(3))) f32x4v*)((__attribute__((address_space(3))) char*)shm+LDS_DK+16*tid)=dv; } }
  DMA_K(0,0);DMA_V(0,0);DMA_K(1,SLOTB);
  bf16x8 qr[4];
  #pragma unroll
  for(int d0=0;d0<4;++d0)qr[d0]=*reinterpret_cast<const bf16x8*>(&Qw[(long)r32*DM+d0*16+hi*8]);
  float mhat=0.f,l_reg=0.f;f32x16 o[2];o[0]=f32x16{};o[1]=f32x16{};f32x16 negm;
  const int qrel=wid*QBLK+r32;
  #define CMASK(P0,P1,t) do{int jb_=(t)-(NT-4); if(jb_>=0)cmask(P0,P1,jb_,qrel,hi);}while(0)
  #define ADDB(P0,P1,t) do{ const lds_fptr dq_=dkl+64*(t)+4*hi; \
    _Pragma("unroll") for(int j_=0;j_<4;++j_){ const f32x4v b0_=*(const __attribute__((address_space(3))) f32x4v*)(dq_+8*j_); const f32x4v b1_=*(const __attribute__((address_space(3))) f32x4v*)(dq_+32+8*j_); \
      P0[4*j_]+=b0_[0];P0[4*j_+1]+=b0_[1];P0[4*j_+2]+=b0_[2];P0[4*j_+3]+=b0_[3]; P1[4*j_]+=b1_[0];P1[4*j_+1]+=b1_[1];P1[4*j_+2]+=b1_[2];P1[4*j_+3]+=b1_[3]; } }while(0)
  bool resc=false;
  #define START(P0,P1) do{ resc=false; _Pragma("unroll") for(int r=0;r<16;++r)P0[r]=__builtin_amdgcn_exp2f(P0[r]); }while(0)
  #define RESC() do{ if(resc){ asm volatile("s_waitcnt lgkmcnt(0)":::"memory"); \
      _Pragma("unroll") for(int d_=0;d_<2;++d_) _Pragma("unroll") for(int r=0;r<16;++r)o[d_][r]*=wsf[crow(r,hi)]; } }while(0)
  f32x16 pA0,pA1,pB0,pB1;
  int sl_prev=0,sl_cur=0,sl_next=SLOTB;
  #define ROT() do{sl_prev=sl_cur;sl_cur=sl_next;sl_next=(sl_next==(NSLOT-1)*SLOTB)?0:sl_next+SLOTB;}while(0)
  DMA_K(2,2*SLOTB);
  WAIT_BAR(3);
  const float dkq=dkl[q0+qrel];
  mhat=dkq+16.0f;
  _Pragma("unroll") for(int r=0;r<16;++r)negm[r]=-mhat; asm volatile("":"+v"(negm));
  qkt(pA0,pA1,Kbase,qr,negm,r32,hi);asm volatile("s_nop 15\n\ts_nop 7":"+v"(pA0),"+v"(pA1));CMASK(pA0,pA1,0);ADDB(pA0,pA1,0);
  START(pA0,pA1);
  _Pragma("unroll") for(int r=0;r<16;++r)pA1[r]=__builtin_amdgcn_exp2f(pA1[r]);
  WAIT_BAR(0);
  DMA_K(3,0);DMA_V(1,SLOTB);
  ROT();
  kload8(kf,kp0+sl_cur);
  WAIT_BAR(2);
  s16x4 vlo[8],vhi[8]; u32x4 pw0,pw1,pw2,pw3;
  #define PKW(P,B) cvtpk_s(P[B],P[B+1])
  #define PAF(k) __builtin_bit_cast(bf16x8,pw##k)
  #define VFR(i) (bf16x8){vlo[i][0],vlo[i][1],vlo[i][2],vlo[i][3],vhi[i][0],vhi[i][1],vhi[i][2],vhi[i][3]}
  #define PIN(x) asm volatile("":"+v"(x))
  #define MX3(a,b,c) __builtin_fmaxf(__builtin_fmaxf((a),(b)),(c))
  #define GAPA(MF,A0,A1,A2,A3,W0,W1,PW) do{ MF; sacc+=A0; sacc+=A1; sacc+=A2; sacc+=A3; PIN(sacc); W0; W1; PIN(PW); SBAR(); }while(0)
  #define EX(v) __builtin_amdgcn_exp2f(v)
  #define GAPB(MF,X,B) do{ MF; X[B]=EX(X[B]); X[B+1]=EX(X[B+1]); X[B+2]=EX(X[B+2]); X[B+3]=EX(X[B+3]); PIN(X); SBAR(); }while(0)
  #define VRD(i) do{ vlo[i]=vtr(vp_+(((i)>>2)*4096+((i)&3)*1024)); vhi[i]=vtr(vp_+(((i)>>2)*4096+((i)&3)*1024+512)); }while(0)
  #define KRD(G,j) do{ if(G){ kload2(kf,kp0+sl_next,j); SBAR(); } }while(0)
  #define STEP(C0,C1,P0,P1,t,GK,GV,GL) do{ SBAR(); \
    const lds_cptr vp_=vp0+sl_prev; \
    VRD(0); SBAR(); float sacc=(P0[0]+P0[1]); \
    GAPA(C0=__builtin_amdgcn_mfma_f32_32x32x16_bf16(kf[0],qr[0],negm,0,0,0), P0[2],P0[3],P0[4],P0[5],     pw0[0]=PKW(P0,0), pw0[1]=PKW(P0,2), pw0); \
    VRD(4); SBAR(); GAPA(C1=__builtin_amdgcn_mfma_f32_32x32x16_bf16(kf[1],qr[0],negm,0,0,0), P0[6],P0[7],P0[8],P0[9],     pw0[2]=PKW(P0,4), pw0[3]=PKW(P0,6), pw0); \
    VRD(1); SBAR(); GAPA(C0=__builtin_amdgcn_mfma_f32_32x32x16_bf16(kf[2],qr[1],C0,0,0,0),   P0[10],P0[11],P0[12],P0[13], pw1[0]=PKW(P0,8), pw1[1]=PKW(P0,10), pw1); \
    VRD(5); SBAR(); GAPA(C1=__builtin_amdgcn_mfma_f32_32x32x16_bf16(kf[3],qr[1],C1,0,0,0),   P0[14],P0[15],P1[0],P1[1],   pw1[2]=PKW(P0,12),pw1[3]=PKW(P0,14), pw1); \
    VRD(2); SBAR(); GAPA(C0=__builtin_amdgcn_mfma_f32_32x32x16_bf16(kf[4],qr[2],C0,0,0,0),   P1[2],P1[3],P1[4],P1[5],     pw2[0]=PKW(P1,0), pw2[1]=PKW(P1,2), pw2); \
    VRD(6); SBAR(); GAPA(C1=__builtin_amdgcn_mfma_f32_32x32x16_bf16(kf[5],qr[2],C1,0,0,0),   P1[6],P1[7],P1[8],P1[9],     pw2[2]=PKW(P1,4), pw2[3]=PKW(P1,6), pw2); \
    VRD(3); SBAR(); GAPA(C0=__builtin_amdgcn_mfma_f32_32x32x16_bf16(kf[6],qr[3],C0,0,0,0),   P1[10],P1[11],P1[12],P1[13], pw3[0]=PKW(P1,8), pw3[1]=PKW(P1,10), pw3); \
    VRD(7); SBAR(); GAPA(C1=__builtin_amdgcn_mfma_f32_32x32x16_bf16(kf[7],qr[3],C1,0,0,0),   P1[14],P1[15],0.f,0.f,       pw3[2]=PKW(P1,12),pw3[3]=PKW(P1,14), pw3); \
    l_reg+=sacc; \
    if(GK){DMA_K((t)+3,sl_cur);} if(GV){DMA_V((t)+1,sl_next);} \
    CMASK(C0,C1,t); ADDB(C0,C1,t); \
      \
    SBAR(); \
    GAPB(o[0]=__builtin_amdgcn_mfma_f32_32x32x16_bf16(PAF(0),VFR(0),o[0],0,0,0), C0,0); \
    GAPB(o[1]=__builtin_amdgcn_mfma_f32_32x32x16_bf16(PAF(0),VFR(4),o[1],0,0,0), C0,4); \
    KRD(GL,0); GAPB(o[0]=__builtin_amdgcn_mfma_f32_32x32x16_bf16(PAF(1),VFR(1),o[0],0,0,0), C0,8); \
    KRD(GL,1); GAPB(o[1]=__builtin_amdgcn_mfma_f32_32x32x16_bf16(PAF(1),VFR(5),o[1],0,0,0), C0,12); \
    KRD(GL,2); GAPB(o[0]=__builtin_amdgcn_mfma_f32_32x32x16_bf16(PAF(2),VFR(2),o[0],0,0,0), C1,0); \
    KRD(GL,3); GAPB(o[1]=__builtin_amdgcn_mfma_f32_32x32x16_bf16(PAF(2),VFR(6),o[1],0,0,0), C1,4); \
    GAPB(o[0]=__builtin_amdgcn_mfma_f32_32x32x16_bf16(PAF(3),VFR(3),o[0],0,0,0), C1,8); \
    GAPB(o[1]=__builtin_amdgcn_mfma_f32_32x32x16_bf16(PAF(3),VFR(7),o[1],0,0,0), C1,12); \
    }while(0)
  int t=1;
  #undef CMASK
  #define CMASK(P0,P1,t) do{}while(0)
  for(;t+5<NT;t+=2){
    STEP(pB0,pB1,pA0,pA1,t,true,true,true);     WAIT_BAR(2); RESC(); ROT();
    STEP(pA0,pA1,pB0,pB1,t+1,true,true,true);   WAIT_BAR(2); RESC(); ROT();
  }
  #undef CMASK
  #define CMASK(P0,P1,t) do{int jb_=(t)-(NT-4); if(jb_>=0)cmask(P0,P1,jb_,qrel,hi);}while(0)
  #define ENDW(tt) do{ if((tt)+3<NT){WAIT_BAR(2);} else if((tt)+2<NT){WAIT_BAR(1);} else {WAIT_BAR(0);} }while(0)
  for(;t+1<NT;t+=2){
    STEP(pB0,pB1,pA0,pA1,t,(t+3<NT),(t+1<NT),(t+1<NT));       ENDW(t);   RESC(); ROT();
    STEP(pA0,pA1,pB0,pB1,t+1,(t+4<NT),(t+2<NT),(t+2<NT));     ENDW(t+1); RESC(); ROT();
  }
  STEP(pB0,pB1,pA0,pA1,NT-1,false,false,false); RESC();
  { float sacc=pB0[0]+pB0[1]; _Pragma("unroll") for(int r=2;r<16;++r)sacc+=pB0[r]; _Pragma("unroll") for(int r=0;r<16;++r)sacc+=pB1[r]; l_reg+=sacc;
    pw0=(u32x4){PKW(pB0,0),PKW(pB0,2),PKW(pB0,4),PKW(pB0,6)};pw1=(u32x4){PKW(pB0,8),PKW(pB0,10),PKW(pB0,12),PKW(pB0,14)};pw2=(u32x4){PKW(pB1,0),PKW(pB1,2),PKW(pB1,4),PKW(pB1,6)};pw3=(u32x4){PKW(pB1,8),PKW(pB1,10),PKW(pB1,12),PKW(pB1,14)};
    SBAR(); pv(o,vb0+sl_cur,PAF(0),PAF(1),PAF(2),PAF(3)); }
  #undef PKW
  #undef PAF
  #undef VFR
  #undef PIN
  #undef MX3
  #undef GAPA
  #undef GAPB
  #undef EX
  #undef VRD
  #undef KRD
  #undef STEP
  #undef ENDW
  {auto rr=__builtin_amdgcn_permlane32_swap(__float_as_uint(l_reg),__float_as_uint(l_reg),false,false);l_reg=__uint_as_float(rr[0])+__uint_as_float(rr[1]);}
  if(hi==0)wsf[32+r32]=l_reg;asm volatile("s_waitcnt lgkmcnt(0)":::"memory");
  float rli[16];
  #pragma unroll
  for(int r=0;r<16;++r)rli[r]=__builtin_amdgcn_rcpf(wsf[32+crow(r,hi)]);
  bf16*Ow=O+(rowbase+q0+wid*QBLK)*ODM+h*D;
  { bf16*stg=(bf16*)(shm+LDS_OST)+wid*2048;
    #pragma unroll
    for(int r=0;r<16;++r){const int orow=crow(r,hi);
      #pragma unroll
      for(int d0=0;d0<2;++d0)stg[orow*64+d0*32+r32]=__float2bfloat16(o[d0][r]*rli[r]);}
    asm volatile("s_waitcnt lgkmcnt(0)":::"memory");
    #pragma unroll
    for(int i=0;i<4;++i){const int row=i*8+(lane>>3),ch=lane&7; const u32x4 v=*(const u32x4*)(stg+row*64+ch*8); ATTN_STORE16(Ow+(long)row*ODM+ch*8,v);
      float s2=0.f; { const unsigned w4[4]={v.x,v.y,v.z,v.w};
        _Pragma("unroll") for(int e=0;e<4;++e){ const float lo=__uint_as_float(w4[e]<<16), hi=__uint_as_float(w4[e]&0xffff0000u); s2+=lo*lo+hi*hi; } }
      s2+=__int_as_float(__builtin_amdgcn_update_dpp(0,__float_as_int(s2),0xB1,0xF,0xF,true)); s2+=__int_as_float(__builtin_amdgcn_update_dpp(0,__float_as_int(s2),0x4E,0xF,0xF,true)); s2+=__int_as_float(__builtin_amdgcn_update_dpp(0,__float_as_int(s2),0x141,0xF,0xF,true));
      if(ch==0) SSB[(rowbase+q0+wid*QBLK+row)*8+h]=s2; } }
  asm volatile("s_waitcnt lgkmcnt(0)\n\ts_barrier":::"memory");
  #undef DMA_K
  #undef DMA_V
  #undef CMASK
  #undef ADDB
  #undef START
  #undef RESC
  #undef ROT
}
constexpr int ATTN_LDS_BYTES=LDS_BYTES;
struct AttnTensors { const bf16* Q; const bf16* K; const bf16* V; bf16* O; const float* DK; float* SSB; };
struct AttnUnit { int bh; int qb; };
struct StaticOrder {
  int vcu, G;
  __device__ __forceinline__ explicit StaticOrder(int grid,int v):vcu(v),G(grid){}
  __device__ __forceinline__ bool next(int i,AttnUnit&u)const{ const int pr=(i>>1)*G+vcu; if(pr>=BATCH*NHEAD*NQB/2)return false; const int s=pr&3; u.bh=pr>>2; u.qb=(i&1)?s:(NQB-1-s); return true; }
  __device__ __forceinline__ void a_ready(const AttnUnit&)const{}
  __device__ __forceinline__ void done(const AttnUnit&)const{}
};
template<class Sched,int THRL=40> __device__ __forceinline__ void attn_phase(char*lds,const AttnTensors&T,const Sched&S,const int widx){
  AttnUnit u;
  for(int i=0;S.next(i,u);++i){ S.a_ready(u); attn_unit<THRL>(u.bh/NHEAD,u.bh%NHEAD,u.qb,T.Q,T.K,T.V,T.O,T.DK+(long)u.bh*SEQ,T.SSB,lds,widx); S.done(u); }
}
#undef SBAR
#undef WAIT_BAR
}
namespace cg = cooperative_groups;
constexpr int NWAVES = 8;
constexpr int BATCH = 16, SEQ = 2048, DM = 1024, M = BATCH * SEQ;
constexpr int DSSM = 512, DATT = 512, NH = 8, NG = 32, NP = 64;
constexpr int DFF = 2752, DFF2 = 5504, NUP = 5632, KDN = 2816, DINP = 2056;
constexpr int NCH = M / 16;
constexpr int KCAT = 384;
constexpr int MH = M / 2;
constexpr float EPS = 1e-6f;
constexpr float LOG2E = 1.4426950408889634f;

constexpr size_t MiB = 1u << 20;
constexpr size_t WS_WIN = 0, WS_WGLU = 4 * MiB, WS_WOUT = 5 * MiB, WS_WUP = 7 * MiB, WS_WDN = 18 * MiB, WS_BSL = 24 * MiB, WS_BSS = 28 * MiB, WS_LS = 34 * MiB, WS_DK = 35 * MiB;
constexpr size_t WS_XN = 36 * MiB, WS_UCAT = 100 * MiB, WS_Q = 148 * MiB, WS_K = 180 * MiB, WS_V = 212 * MiB, WS_SLOC = 244 * MiB, WS_Y = 276 * MiB, WS_YS = 308 * MiB, WS_MIX = 340 * MiB;
constexpr size_t WS_A16 = 4 * MiB + 512 * 1024;
constexpr size_t WS_OB = 404 * MiB;
constexpr size_t WS_CTL = 4 * MiB + 640 * 1024;
constexpr size_t WS_UFF = 100 * MiB, WS_ACT = 276 * MiB, WS_END = 452 * MiB;
static_assert(WS_UFF + (size_t)MH * NUP * 2 <= WS_ACT && WS_ACT + (size_t)M * KDN * 2 <= WS_END && WS_WDN + (size_t)1024 * KDN * 2 <= WS_BSL && WS_WUP + (size_t)NUP * 1024 * 2 <= WS_WDN, "d_ws map");

constexpr int RING_BYTES = 131072, MISC_OFF = RING_BYTES + 320, LDS_BYTES = 147456;
#define LAS __attribute__((address_space(3)))
typedef unsigned short bf16;
typedef unsigned v4u __attribute__((ext_vector_type(4)));
typedef unsigned v2u __attribute__((ext_vector_type(2)));
typedef float f32x4 __attribute__((ext_vector_type(4)));
#define LDS_WAIT() asm volatile("s_waitcnt lgkmcnt(0)" ::: "memory")
__device__ __forceinline__ unsigned pk2(float lo, float hi) { return pg8::cvt_pk_bf16(lo, hi); }
template <int CTRL> __device__ __forceinline__ float dppf(float v) { return __int_as_float(__builtin_amdgcn_update_dpp(0, __float_as_int(v), CTRL, 0xF, 0xF, true)); }
__device__ __forceinline__ float wave_sum(float v) {
    v += dppf<0xB1>(v); v += dppf<0x4E>(v); v += dppf<0x141>(v); v += dppf<0x140>(v);
    const int i = __float_as_int(v);
    return (__int_as_float(__builtin_amdgcn_readlane(i, 0)) + __int_as_float(__builtin_amdgcn_readlane(i, 16))) + (__int_as_float(__builtin_amdgcn_readlane(i, 32)) + __int_as_float(__builtin_amdgcn_readlane(i, 48)));
}
#define XB_TMO      128
#define XB_XCNT(j)  (256  + 64 * (j))
#define XB_XSUB(j)  (1280 + 64 * (j))
#define XB_XGEN(j)  (2304 + 64 * (j))
#define XB_TOP      3328
#define XB_TOPGEN   3392
#define XCD_BAR_WORDS 3456
#define XB_SPIN_CAP (1u << 18)

__device__ __forceinline__ unsigned xb_ld(unsigned* p)              { return __hip_atomic_load(p, __ATOMIC_RELAXED, __HIP_MEMORY_SCOPE_AGENT); }
__device__ __forceinline__ unsigned xb_add(unsigned* p, unsigned v) { return __hip_atomic_fetch_add(p, v, __ATOMIC_RELAXED, __HIP_MEMORY_SCOPE_AGENT); }
__device__ __forceinline__ unsigned xb_xcc_id() { return (unsigned)__builtin_amdgcn_s_getreg((3 << 11) | 20) & 0xFu; }
#define XB_SPIN(cond, bar) do { unsigned _sp = 0; while (cond) { __builtin_amdgcn_s_sleep(1); \
    if ((++_sp & 255u) == 0u) { if (xb_ld(&(bar)[XB_TMO])) break; if (_sp > XB_SPIN_CAP) { atomicAdd(&(bar)[XB_TMO], 1u); break; } } } } while (0)

struct XcdBarrier {
    unsigned* bar; unsigned x;
    volatile LAS unsigned* st;
};

__device__ __forceinline__ XcdBarrier xcd_barrier_post(unsigned* bar, volatile LAS unsigned* st) {
    XcdBarrier b; b.bar = bar; b.x = xb_xcc_id(); b.st = st;
    if (threadIdx.x == 0) (void)xb_add(&bar[XB_XCNT(b.x)], 1u);
    return b;
}
__device__ __forceinline__ void xcd_barrier_complete(unsigned* bar, unsigned x, unsigned& nloc, unsigned& nx) {
    const unsigned G = gridDim.x * gridDim.y * gridDim.z;
    unsigned sum, cnt, mine, sp = 0u;
    for (;;) {
        sum = 0u; cnt = 0u; mine = 0u;
#pragma unroll
        for (unsigned j = 0; j < 16; ++j) { const unsigned c = xb_ld(&bar[XB_XCNT(j)]); sum += c; cnt += (c > 0u) ? 1u : 0u; mine = (j == x) ? c : mine; }
        if (sum == G) break;
        __builtin_amdgcn_s_sleep(1);
        if ((++sp & 255u) == 0u) { if (xb_ld(&bar[XB_TMO])) break; if (sp > XB_SPIN_CAP) { atomicAdd(&bar[XB_TMO], 1u); break; } }
    }
    nloc = mine > 0u ? mine : 1u; nx = cnt > 0u ? cnt : 1u;
}

__device__ __forceinline__ void xcd_barrier(const XcdBarrier& b) {
    asm volatile("s_waitcnt vmcnt(0)" ::: "memory");
    __syncthreads();
    if (threadIdx.x == 0) {
        unsigned* bar = b.bar;
        __builtin_amdgcn_s_waitcnt(0);
        unsigned nloc = b.st[0], nx = b.st[1];
        if (nloc == 0u) { xcd_barrier_complete(bar, b.x, nloc, nx); b.st[0] = nloc; b.st[1] = nx; }
        const unsigned old = xb_add(&bar[XB_XSUB(b.x)], 1u);
        const unsigned gen = old / nloc;
        if (old + 1u == (gen + 1u) * nloc) {
            __builtin_amdgcn_fence(__ATOMIC_RELEASE, "agent");
            asm volatile("s_waitcnt vmcnt(0)" ::: "memory");
            const unsigned og = xb_add(&bar[XB_TOP], 1u);
            const unsigned tg = og / nx;
            if (og + 1u == (tg + 1u) * nx) xb_add(&bar[XB_TOPGEN], 1u);
            else XB_SPIN(xb_ld(&bar[XB_TOPGEN]) == tg, bar);
            __builtin_amdgcn_fence(__ATOMIC_ACQUIRE, "agent");
            xb_add(&bar[XB_XGEN(b.x)], 1u);
            asm volatile("s_waitcnt vmcnt(0)" ::: "memory");
        } else {
            XB_SPIN(xb_ld(&bar[XB_XGEN(b.x)]) == gen, bar);
            __builtin_amdgcn_fence(__ATOMIC_ACQUIRE, "agent");
            asm volatile("s_waitcnt vmcnt(0)" ::: "memory");
        }
    }
    __syncthreads();
}

struct Args { const float* in[24]; float* out; unsigned char* ws; };
enum { I_X = 0, I_NMIX, I_WIN, I_BF, I_LRE, I_LIM, I_BRE, I_BIM, I_CRE, I_CIM, I_DSK, I_LDT, I_WGLU, I_BGLU, I_QN, I_KN, I_NOS, I_NOA, I_WOUT, I_NFFN, I_WUP, I_CW, I_CB, I_WDN };

__device__ __forceinline__ void p0_transpose_item(const float* W, int ldw, int nblk, bf16* WT, int ldo, LAS float* scr, int item, int lane, const bool permqk = false, const bool upmap = false, const float* gsc = nullptr) {
    const int kb = item / nblk, nb = item % nblk, k0 = 64 * kb, n0 = 32 * nb;
    const int d0 = upmap ? (n0 < 2752 ? ((n0 >> 7) * 256 + (n0 & 127)) : (((n0 - 2752) >> 7) * 256 + 128 + ((n0 - 2752) & 127))) : (permqk && n0 >= 512 && n0 < 1536) ? ((n0 & ~255) | (((n0 >> 5) & 1) << 7) | (((n0 >> 6) & 3) << 5)) : n0;
#pragma unroll
    for (int i = 0; i < 32; ++i) { const int kk = 2 * i + (lane >> 5); scr[kk * 33 + (lane & 31)] = W[(size_t)(k0 + kk) * ldw + n0 + (lane & 31)] * (gsc ? gsc[k0 + kk] : 1.f); }
    LDS_WAIT(); asm volatile("" ::: "memory");
    const int c = lane & 7;
#pragma unroll
    for (int j = 0; j < 4; ++j) { const int n = (lane >> 3) + 8 * j; const LAS float* s = scr + (8 * c) * 33 + n;
        v4u o; o.x = pk2(s[0 * 33], s[1 * 33]); o.y = pk2(s[2 * 33], s[3 * 33]); o.z = pk2(s[4 * 33], s[5 * 33]); o.w = pk2(s[6 * 33], s[7 * 33]);
        *(v4u*)(WT + (size_t)(d0 + n) * ldo + k0 + 8 * c) = o; }
    LDS_WAIT(); asm volatile("" ::: "memory");
}
struct Cplx { float re, im; };
__device__ __forceinline__ Cplx s5_apow(float lr, float li, float dt, int d) { const float mg = expf(lr * dt * (float)d), an = li * dt * (float)d; return Cplx{mg * cosf(an), mg * sinf(an)}; }
__device__ __forceinline__ Cplx s5_q(float lr, float li, float dt) {
    const float th = li * dt, sh = sinf(0.5f * th), em = expm1f(lr * dt); const float nr = em * cosf(th) - 2.f * sh * sh, ni = (em + 1.f) * sinf(th), den = lr * lr + li * li; return Cplx{(nr * lr + ni * li) / den, (ni * lr - nr * li) / den}; }


__device__ __forceinline__ void ssm_pair(LAS unsigned char* lds, const bf16* __restrict__ Uc, const bf16* __restrict__ Bsl, const bf16* __restrict__ Bss, const float* __restrict__ A16, bf16* __restrict__ Y, const int b, const int g, const int tid, const float* __restrict__ LSp, float* __restrict__ DKp, const int cbh, v4u (&uv)[8], const int nb, const int ng) {
    typedef short bf16x8v __attribute__((ext_vector_type(8)));
    const int lane = tid & 63, wave = __builtin_amdgcn_readfirstlane(tid >> 6), l15 = lane & 15, quad = lane >> 4;
    LAS unsigned char* const sU = lds; LAS unsigned char* const sS = lds + 65536;
    bf16x8v wb[8];
    { const bf16* wrow = Bsl + (size_t)g * 65536 + (size_t)(16 * wave + l15) * 256 + quad * 8;
#pragma unroll
      for (int ks = 0; ks < 8; ++ks) wb[ks] = *(const bf16x8v*)(wrow + ks * 32); }
    {
#pragma unroll
      for (int i = 0; i < 8; ++i) { const int idx = tid + 512 * i, row = idx >> 5, q = idx & 31; *(LAS v4u*)(sU + row * 512 + ((q ^ (row & 15)) << 4)) = uv[i]; } }
    __syncthreads();
    {
        f32x4 acc[8];
#pragma unroll
        for (int mt = 0; mt < 8; ++mt) acc[mt] = (f32x4){0.f, 0.f, 0.f, 0.f};
#pragma unroll
        for (int mt = 0; mt < 8; ++mt)
#pragma unroll
            for (int ks = 0; ks < 8; ++ks) { const bf16x8v a = *(const LAS bf16x8v*)(sU + (16 * mt + l15) * 512 + (((ks * 4 + quad) ^ l15) << 4));
                acc[mt] = __builtin_amdgcn_mfma_f32_16x16x32_bf16(a, wb[ks], acc[mt], 0, 0, 0); }
#pragma unroll
        for (int mt = 0; mt < 8; ++mt)
#pragma unroll
            for (int j = 0; j < 4; ++j) ((LAS float*)sS)[(16 * mt + quad * 4 + j) * 128 + 16 * wave + l15] = acc[mt][j];
    }
    bf16x8v yb[2][12];
#pragma unroll
    for (int n2 = 0; n2 < 2; ++n2) { const bf16* brow = Bss + (size_t)g * (256 * 384) + (size_t)(16 * (2 * wave + n2) + l15) * 384 + quad * 8;
#pragma unroll
        for (int ks = 0; ks < 12; ++ks) yb[n2][ks] = *(const bf16x8v*)(brow + ks * 32); }
    if (nb >= 0) { const v4u* src = (const v4u*)(Uc + ((size_t)ng * 2048 + (size_t)nb * 128) * 256);
#pragma unroll
        for (int i = 0; i < 8; ++i) uv[i] = src[tid + 512 * i]; }
    __syncthreads();
    if (wave == 0) {
        const int p = lane; const float ar = A16[(g * 64 + p) * 2], ai = A16[(g * 64 + p) * 2 + 1]; float xr = 0.f, xi = 0.f;
        for (int c0 = 0; c0 < 128; c0 += 8) { float sr[8], si[8];
#pragma unroll
            for (int j = 0; j < 8; ++j) { sr[j] = ((const LAS float*)sS)[(c0 + j) * 128 + p]; si[j] = ((const LAS float*)sS)[(c0 + j) * 128 + 64 + p]; }
            asm volatile("s_waitcnt lgkmcnt(0)" ::: "memory");
#pragma unroll
            for (int j = 0; j < 8; ++j) { const unsigned w = pk2(xr, xi); *(LAS bf16*)(sS + (c0 + j) * 512 + 2 * p) = (bf16)(w & 0xffffu); *(LAS bf16*)(sS + (c0 + j) * 512 + 128 + 2 * p) = (bf16)(w >> 16);
                const float nr = ar * xr - ai * xi + sr[j], ni = ar * xi + ai * xr + si[j]; xr = nr; xi = ni; }
            asm volatile("" ::: "memory"); }
    }
    if (wave == 1) {
        const int cb = cbh >> 3, ch = cbh & 7; const float* lsp = LSp + ((size_t)cb * 2048 + 32 * lane) * 8 + ch;
        float lv[32]; float loc = 0.f;
#pragma unroll
        for (int i = 0; i < 32; ++i) { lv[i] = lsp[i * 8]; }
#pragma unroll
        for (int i = 0; i < 32; ++i) loc += lv[i];
        float inc = loc;
#pragma unroll
        for (int o = 1; o < 64; o <<= 1) { const float t = __shfl_up(inc, o); if (lane >= o) inc += t; }
        float run = inc - loc; float* dk = DKp + (size_t)cbh * 2048 + 32 * lane;
#pragma unroll
        for (int i = 0; i < 32; i += 4) { f32x4 o4; run += lv[i]; o4[0] = -1.4426950408889634f * run; run += lv[i + 1]; o4[1] = -1.4426950408889634f * run; run += lv[i + 2]; o4[2] = -1.4426950408889634f * run; run += lv[i + 3]; o4[3] = -1.4426950408889634f * run; *(f32x4*)(dk + i) = o4; }
        asm volatile("s_waitcnt vmcnt(0)" ::: "memory");
    }
    __syncthreads();
    {
        f32x4 ya[2][8];
#pragma unroll
        for (int n2 = 0; n2 < 2; ++n2)
#pragma unroll
            for (int mt = 0; mt < 8; ++mt) ya[n2][mt] = (f32x4){0.f, 0.f, 0.f, 0.f};
#pragma unroll
        for (int mt = 0; mt < 8; ++mt)
#pragma unroll
            for (int ks = 0; ks < 12; ++ks) {
                const bf16x8v f = ks < 8 ? *(const LAS bf16x8v*)(sU + (16 * mt + l15) * 512 + (((ks * 4 + quad) ^ l15) << 4)) : *(const LAS bf16x8v*)(sS + (16 * mt + l15) * 512 + (((ks - 8) * 4 + quad) << 4));
                ya[0][mt] = __builtin_amdgcn_mfma_f32_16x16x32_bf16(yb[0][ks], f, ya[0][mt], 0, 0, 0);
                ya[1][mt] = __builtin_amdgcn_mfma_f32_16x16x32_bf16(yb[1][ks], f, ya[1][mt], 0, 0, 0); }
        __syncthreads();
#pragma unroll
        for (int n2 = 0; n2 < 2; ++n2)
#pragma unroll
            for (int mt = 0; mt < 8; ++mt) { const int tl = 16 * (16 * mt + l15) + 2 * wave + n2; const f32x4 v = ya[n2][mt];
                v2u w; w.x = pk2(pg8::gelu_tanh(v[0]), pg8::gelu_tanh(v[1])); w.y = pk2(pg8::gelu_tanh(v[2]), pg8::gelu_tanh(v[3]));
                *(LAS v2u*)(sU + tl * 32 + quad * 8) = w; }
        __syncthreads();
        { v4u* dst = (v4u*)(Y + ((size_t)g * 32768 + (size_t)b * 2048) * 16);
#pragma unroll
          for (int i = 0; i < 8; ++i) dst[tid + 512 * i] = *(const LAS v4u*)(sU + (tid + 512 * i) * 16); }
    }
    __syncthreads();
}

__global__ void __launch_bounds__(NWAVES * 64, 2) hymba_fwd(Args args) {
    extern __shared__ __attribute__((aligned(16))) unsigned char lds[];
    cg::grid_group grid = cg::this_grid();
    LAS unsigned char* const ldsp = (LAS unsigned char*)lds;
    const int widx = __builtin_amdgcn_readfirstlane((int)threadIdx.x >> 6);
    const int G = gridDim.x; const int bx = blockIdx.x; const int vcu = (G % 8 == 0) ? (bx % 8) * (G / 8) + bx / 8 : bx;
    const int NGW = G * NWAVES;
#define PHASE_IDS const int tid = fresh_tid(widx), lane = tid & 63, wave = __builtin_amdgcn_readfirstlane(tid >> 6), gw = vcu * NWAVES + wave; (void)lane; (void)gw
    unsigned char* const ws = args.ws;
    unsigned* const barw = (unsigned*)(ws + WS_CTL);
    { PHASE_IDS;
      for (int u = tid; u < (LDS_BYTES - RING_BYTES) / 4; u += NWAVES * 64) ((LAS unsigned*)(ldsp + RING_BYTES))[u] = 0u;
      __syncthreads(); }
    if (ws == nullptr) grid.sync();
    const XcdBarrier bar = xcd_barrier_post(barw, (volatile LAS unsigned*)(ldsp + MISC_OFF) + 8);
    const float* const x = args.in[I_X]; float* const out = args.out;
    bf16* const Win_t = (bf16*)(ws + WS_WIN); bf16* const Wglu_t = (bf16*)(ws + WS_WGLU); bf16* const Wout_t = (bf16*)(ws + WS_WOUT); bf16* const Wup_t = (bf16*)(ws + WS_WUP); bf16* const Wdn_t = (bf16*)(ws + WS_WDN);
    bf16* const Bsl = (bf16*)(ws + WS_BSL); bf16* const Bss = (bf16*)(ws + WS_BSS); float* const LS = (float*)(ws + WS_LS); float* const DK = (float*)(ws + WS_DK);
    bf16* const XN = (bf16*)(ws + WS_XN); bf16* const Ucat = (bf16*)(ws + WS_UCAT); bf16* const Qb = (bf16*)(ws + WS_Q); bf16* const Kb = (bf16*)(ws + WS_K); bf16* const Vb = (bf16*)(ws + WS_V);
    float* const Sloc = (float*)(ws + WS_SLOC); bf16* const Yb = (bf16*)(ws + WS_Y); bf16* const YS = (bf16*)(ws + WS_YS); bf16* const MIX = (bf16*)(ws + WS_MIX);
    float* const A16 = (float*)(ws + WS_A16); bf16* const OB = (bf16*)(ws + WS_OB);
    bf16* const RAWB = (bf16*)(ws + WS_UFF);
    bf16* const ACT = (bf16*)(ws + WS_ACT);
    float* const RS0 = (float*)(ws + WS_CTL + 65536 + 131072);
    float* const RS = (float*)(ws + WS_CTL + 65536);
    float* const SS = (float*)(ws + WS_YS);
    float* const RATIO = (float*)(ws + WS_YS + 2 * MiB); float* const RS2X = (float*)(ws + WS_YS + 2 * MiB + 256 * 1024);
    float* const SSB = (float*)(ws + WS_LS);
    float* const SSA = (float*)(ws + WS_DK);

    {
        PHASE_IDS;
        LAS float* scr = (LAS float*)(ldsp + wave * 16384);
        constexpr int I_IN = 16 * 64, I_GL = 8 * 16, I_OU = 16 * 32, I_UP = 16 * 172, I_DN = 43 * 32;
        constexpr int T_END = I_IN + I_GL + I_OU + I_UP + I_DN, Z_UP = 32, Z_DN = 16, S_A = NG * 16, S_B = NG * 16, S_C = NG * 16, S_D = NG;
        constexpr int NITEMS = T_END + Z_UP + Z_DN + S_A + S_B + S_C + S_D;
        for (int it = gw; it < NITEMS; it += NGW) {
            int r = it < 1536 ? it : (it < 2048 ? it + (5840 - 1536) : (it < 6352 ? it - 512 : it));
            if (r < I_IN) { p0_transpose_item(args.in[I_WIN], DINP, 64, Win_t, 1024, scr, r, lane, true); continue; } r -= I_IN;
            if (r < I_GL) { p0_transpose_item(args.in[I_WGLU], 512, 16, Wglu_t, 512, scr, r, lane); continue; } r -= I_GL;
            if (r < I_OU) { p0_transpose_item(args.in[I_WOUT], 1024, 32, Wout_t, 1024, scr, r, lane, false, false, (r / 32) < 8 ? args.in[I_NOS] : args.in[I_NOA] - 512); continue; }     r -= I_OU;
            if (r < I_UP) { p0_transpose_item(args.in[I_WUP], DFF2, 172, Wup_t, 1024, scr, r, lane, false, true, args.in[I_NFFN]); continue; } r -= I_UP;
            if (r < I_DN) { p0_transpose_item(args.in[I_WDN], 1024, 32, Wdn_t, KDN, scr, r, lane); continue; } r -= I_DN;
            if (r < Z_UP) {
                for (int i = lane; i < 512; i += 64) { const int idx = 4 * r + (i >> 7); const int row = 21 * 256 + (idx < 64 ? 64 + idx : 192 + (idx - 64)); *((v4u*)(Wup_t + (size_t)row * 1024) + (i & 127)) = (v4u){0u, 0u, 0u, 0u}; }
                continue; } r -= Z_UP;
            if (r < Z_DN) { for (int i = lane; i < 64 * 8; i += 64) { const int row = r * 64 + (i >> 3); *(v4u*)(Wdn_t + (size_t)row * KDN + DFF + 8 * (i & 7)) = (v4u){0u, 0u, 0u, 0u}; } continue; } r -= Z_DN;
            const int p = lane;
            if (r < S_A) {
                const int g = r >> 4, d = r & 15;
                const float dt = expf(args.in[I_LDT][g]), lr = args.in[I_LRE][g * 64 + p], li = args.in[I_LIM][g * 64 + p];
                const Cplx ad = s5_apow(lr, li, dt, d), q = s5_q(lr, li, dt);
#pragma unroll 4
                for (int h = 0; h < 16; ++h) { const float cr = args.in[I_CRE][(g * 16 + h) * 64 + p], ci = args.in[I_CIM][(g * 16 + h) * 64 + p];
                    scr[h * 64 + p] = (float)(cr * ad.re - ci * ad.im); scr[1024 + h * 64 + p] = (float)(cr * ad.im + ci * ad.re); }
#pragma unroll 4
                for (int h = 0; h < 16; ++h) { const float br = args.in[I_BRE][(g * 64 + p) * 16 + h], bi = args.in[I_BIM][(g * 64 + p) * 16 + h];
                    scr[2048 + p * 16 + h] = (float)(q.re * br - q.im * bi); scr[3072 + p * 16 + h] = (float)(q.re * bi + q.im * br); }
                LDS_WAIT(); asm volatile("" ::: "memory");
                const int h = lane >> 2, hp0 = 4 * (lane & 3); f32x4 acc = (f32x4){0.f, 0.f, 0.f, 0.f};
                for (int pp = 0; pp < 64; ++pp) { const float car = scr[h * 64 + pp], cai = scr[1024 + h * 64 + pp]; const f32x4 bbr = *(const LAS f32x4*)(scr + 2048 + pp * 16 + hp0), bbi = *(const LAS f32x4*)(scr + 3072 + pp * 16 + hp0);
                    acc += car * bbr - cai * bbi; }
                if (d == 0) { const float dsk = args.in[I_DSK][g * 16 + h];
#pragma unroll
                    for (int i = 0; i < 4; ++i) if (hp0 + i == h) acc[i] += dsk; }
                v2u w; w.x = pk2(acc[0], acc[1]); w.y = pk2(acc[2], acc[3]);
                bf16* Bg = Bss + (size_t)g * 256 * KCAT;
                for (int t = d; t < 16; ++t) *(v2u*)(Bg + (size_t)(t * 16 + h) * KCAT + (t - d) * 16 + hp0) = w;
                if (d > 0) for (int t = 0; t + d < 16; ++t) *(v2u*)(Bg + (size_t)(t * 16 + h) * KCAT + (t + d) * 16 + hp0) = (v2u){0u, 0u};
                LDS_WAIT(); asm volatile("" ::: "memory");
                continue; } r -= S_A;
            if (r < S_B) {
                const int g = r >> 4, t = r & 15;
                const float dt = expf(args.in[I_LDT][g]), lr = args.in[I_LRE][g * 64 + p], li = args.in[I_LIM][g * 64 + p];
                const Cplx a = s5_apow(lr, li, dt, t + 1);
                if (t == 15) { A16[(g * 64 + p) * 2] = (float)a.re; A16[(g * 64 + p) * 2 + 1] = (float)a.im; }
                bf16* Bg = Bss + (size_t)g * 256 * KCAT;
                for (int h = 0; h < 16; ++h) { const float cr = args.in[I_CRE][(g * 16 + h) * 64 + p], ci = args.in[I_CIM][(g * 16 + h) * 64 + p];
                    const unsigned w = pk2((float)(cr * a.re - ci * a.im), (float)(-(cr * a.im + ci * a.re)));
                    Bg[(size_t)(t * 16 + h) * KCAT + 256 + p] = (bf16)(w & 0xffffu); Bg[(size_t)(t * 16 + h) * KCAT + 320 + p] = (bf16)(w >> 16); }
                continue; } r -= S_B;
            if (r < S_C) {
                const int g = r >> 4, s = r & 15;
                const float dt = expf(args.in[I_LDT][g]), lr = args.in[I_LRE][g * 64 + p], li = args.in[I_LIM][g * 64 + p];
                const Cplx a = s5_apow(lr, li, dt, 15 - s), q = s5_q(lr, li, dt);
                bf16* Bg = Bsl + (size_t)g * 256 * 256;
                unsigned wr_[8], wi_[8];
#pragma unroll
                for (int h2 = 0; h2 < 8; ++h2) { float vr[2], vi[2];
#pragma unroll
                    for (int e = 0; e < 2; ++e) { const int h = 2 * h2 + e; const float br = args.in[I_BRE][(g * 64 + p) * 16 + h], bi = args.in[I_BIM][(g * 64 + p) * 16 + h];
                        const float bbr = q.re * br - q.im * bi, bbi = q.re * bi + q.im * br; vr[e] = (float)(a.re * bbr - a.im * bbi); vi[e] = (float)(a.re * bbi + a.im * bbr); }
                    wr_[h2] = pk2(vr[0], vr[1]); wi_[h2] = pk2(vi[0], vi[1]); }
                v4u* pr = (v4u*)(Bg + (size_t)p * 256 + s * 16); v4u* pi = (v4u*)(Bg + (size_t)(64 + p) * 256 + s * 16);
                pr[0] = (v4u){wr_[0], wr_[1], wr_[2], wr_[3]}; pr[1] = (v4u){wr_[4], wr_[5], wr_[6], wr_[7]};
                pi[0] = (v4u){wi_[0], wi_[1], wi_[2], wi_[3]}; pi[1] = (v4u){wi_[4], wi_[5], wi_[6], wi_[7]};
                continue; } r -= S_C;
            { v4u* pz = (v4u*)(Bsl + (size_t)r * 256 * 256 + 128 * 256);
              for (int i = lane; i < 4096; i += 64) pz[i] = (v4u){0u, 0u, 0u, 0u}; }
        }
        __syncthreads();
        LAS float* wfT = (LAS float*)ldsp;
        for (int i = tid; i < 8192; i += NWAVES * 64) { const int k = i >> 3, h = i & 7; wfT[h * 1024 + k] = args.in[I_WIN][(size_t)k * DINP + 2048 + h]; }
        __syncthreads();
        f32x4 gn[4];
#pragma unroll
        for (int j = 0; j < 4; ++j) gn[j] = *((const f32x4*)args.in[I_NMIX] + lane + 64 * j);
        const float bfg = args.in[I_BF][lane & 7];
        f32x4 nx[4];
        if (gw < M) {
#pragma unroll
            for (int j = 0; j < 4; ++j) nx[j] = ((const f32x4*)(x + (size_t)gw * DM) + lane)[64 * j];
        }
        for (int m = gw; m < M; m += NGW) {
            f32x4 v[4]; float s2 = 0.f;
#pragma unroll
            for (int j = 0; j < 4; ++j) v[j] = nx[j];
            if (m + NGW < M) {
#pragma unroll
                for (int j = 0; j < 4; ++j) nx[j] = ((const f32x4*)(x + (size_t)(m + NGW) * DM) + lane)[64 * j];
            }
#pragma unroll
            for (int j = 0; j < 4; ++j) s2 += (v[j].x * v[j].x + v[j].y * v[j].y) + (v[j].z * v[j].z + v[j].w * v[j].w);
            const float irs = sqrtf(wave_sum(s2) * (1.f / DM) + EPS), rs = 1.0f / irs; if (lane == 0) RS0[m] = irs;
            unsigned long long* o8 = (unsigned long long*)(XN + (size_t)m * DM) + lane;
#pragma unroll
            for (int j = 0; j < 4; ++j) { v[j] = v[j] * rs * gn[j]; o8[64 * j] = (unsigned long long)pk2(v[j].x, v[j].y) | ((unsigned long long)pk2(v[j].z, v[j].w) << 32); }
            float fl = 0.f;
#pragma unroll
            for (int h = 0; h < 8; ++h) { float a = 0.f;
#pragma unroll
                for (int j = 0; j < 4; ++j) { const f32x4 w = *(const LAS f32x4*)(wfT + h * 1024 + 256 * j + 4 * lane); a += (v[j].x * w.x + v[j].y * w.y) + (v[j].z * w.z + v[j].w * w.w); }
                a = wave_sum(a); if ((lane & 7) == h) fl = a; }
            if (lane < 8) { const float f = fl + bfg; LS[(size_t)m * 8 + lane] = fminf(f, 0.f) - log1pf(expf(-fabsf(f))); }
        }
    }
    xcd_barrier(bar);
    {
        pg8::Gemm g{XN, Win_t, 1024, 1024, 1024, 0, 0}; pg8::StaticOrder S; S.init(M, 2048, G, bx);
        pg8::EpiProj E{Ucat, Qb, Kb, Vb, args.in[I_QN], args.in[I_KN]};
        pg8::gemm_phase<pg8::EpiProj, pg8::StaticOrder, true, true>(ldsp, g, S, E, widx);
    }
    xcd_barrier(bar);
    { v4u uv[8];
      if (bx < BATCH * NG) { PHASE_IDS; const v4u* src = (const v4u*)(Ucat + ((size_t)(bx & 31) * 2048 + (size_t)(bx >> 5) * 128) * 256);
#pragma unroll
          for (int i = 0; i < 8; ++i) uv[i] = src[tid + 512 * i]; }
      int k = 0; for (int pi = bx; pi < BATCH * NG; pi += G, ++k) { PHASE_IDS; const int pn_ = pi + G; const bool hn_ = pn_ < BATCH * NG;
          ssm_pair(ldsp, Ucat, Bsl, Bss, A16, Yb, pi >> 5, pi & 31, tid, LS, DK, (k * G + vcu) >> 2, uv, hn_ ? (pn_ >> 5) : -1, pn_ & 31); } }
    {
        const attn_body::AttnTensors AT{(const attn_body::bf16*)Qb, (const attn_body::bf16*)Kb, (const attn_body::bf16*)Vb, (attn_body::bf16*)(MIX + 512), DK, SSB};
        const attn_body::StaticOrder S(G, vcu);
        attn_body::attn_phase<attn_body::StaticOrder>((char*)lds, AT, S, widx);
    }
    xcd_barrier(bar);
    {
        pg8::Gemm g{Yb, Wglu_t, 512, 512, 512, 0, 0, M}; pg8::StaticOrder S; S.init(M, 512, G, bx);
        pg8::EpiGlu E{Yb, MIX, args.in[I_BGLU], SSA};
        pg8::gemm_phase<pg8::EpiGlu, pg8::StaticOrder, true, true>(ldsp, g, S, E, widx);
    }
    xcd_barrier(bar);
    {
        pg8::Gemm g{MIX, Wout_t, 1024, 1024, 1024, 0, 0}; pg8::StaticOrder S; S.init(M, 1024, G, bx);
        {
            PHASE_IDS; pg8::Unit uu;
            for (int i = tid >> 8; S.next(i, uu); i += 2) { const int row = uu.pm * 256 + (tid & 255);
                const f32x4* pa = (const f32x4*)(SSA + (size_t)row * 8); const f32x4* pb = (const f32x4*)(SSB + (size_t)row * 8);
                const f32x4 a4 = pa[0] + pa[1], b4 = pb[0] + pb[1];
                const float r1 = 1.0f / sqrtf(((a4[0] + a4[1]) + (a4[2] + a4[3])) * (1.f / 512.f) + EPS), r2 = 1.0f / sqrtf(((b4[0] + b4[1]) + (b4[2] + b4[3])) * (1.f / 512.f) + EPS);
                RATIO[row] = r1 / r2; RS2X[row] = r2; }
            asm volatile("s_waitcnt vmcnt(0)" ::: "memory"); __syncthreads(); asm volatile("buffer_inv sc1" ::: "memory");
        }
        pg8::EpiResSq E{x, out, XN, SS, RATIO, RS2X, RS0, args.in[I_NMIX]};
        pg8::gemm_phase<pg8::EpiResSq, pg8::StaticOrder, true, true>(ldsp, g, S, E, widx);
    }
    xcd_barrier(bar);
    {
        PHASE_IDS;
        for (int row = vcu * (NWAVES * 64) + tid; row < M; row += G * NWAVES * 64) { const f32x4* sp = (const f32x4*)(SS + (size_t)row * 16); const f32x4 s4 = (sp[0] + sp[1]) + (sp[2] + sp[3]);
            RS[row] = 1.0f / sqrtf(((s4[0] + s4[1]) + (s4[2] + s4[3])) * (1.f / 1024.f) + EPS); }
    }
    xcd_barrier(bar);
    {
        pg8::Gemm g{XN, Wup_t, 1024, 1024, 1024, 0, 0}; pg8::StaticOrder S; S.init(M, NUP, G, bx);
        pg8::EpiUpConv E{ACT, RAWB, args.in[I_CW], args.in[I_CB], RS};
        pg8::gemm_phase<pg8::EpiUpConv, pg8::StaticOrder, true, true>(ldsp, g, S, E, widx);
    }
    xcd_barrier(bar);
    {
        PHASE_IDS;
        const float* cw = args.in[I_CW]; const float* cb = args.in[I_CB];
        const int gt = vcu * (NWAVES * 64) + tid, NT_ = G * NWAVES * 64;
        for (int it = gt; it < (M / 256) * 4 * 352; it += NT_) { const int cgp = it % 352, rest = it / 352, which = rest & 3, pm = rest >> 2;
            const int rho = (which & 1) + (which >> 1) * 128;
            bf16* ap = ACT + ((size_t)pm * 256 + rho) * KDN + 8 * cgp;
            if (cgp >= 344) { *(v4u*)ap = (v4u){0u, 0u, 0u, 0u}; continue; }
            const int j = 8 * cgp; const bool seq0 = (pm & 7) == 0;
            const int sx = which == 0 ? 0 : which == 1 ? 1 : which == 2 ? 4 : 5;
            const int s1 = which == 0 ? -1 : which == 1 ? 0 : which == 2 ? 3 : 4;
            const int s2 = which == 0 ? -2 : which == 1 ? -1 : which == 2 ? 2 : 3;
            const bool z1 = seq0 && s1 < 0, z2 = seq0 && s2 < 0;
            const bf16* rb = RAWB + (size_t)pm * 8 * NUP + j;
            const v4u zz = (v4u){0u, 0u, 0u, 0u};
            const v4u a0 = *(const v4u*)(rb + (ptrdiff_t)sx * NUP), c0 = *(const v4u*)(rb + (ptrdiff_t)sx * NUP + KDN);
            const v4u a1 = z1 ? zz : *(const v4u*)(rb + (ptrdiff_t)s1 * NUP), c1 = z1 ? zz : *(const v4u*)(rb + (ptrdiff_t)s1 * NUP + KDN);
            const v4u a2 = z2 ? zz : *(const v4u*)(rb + (ptrdiff_t)s2 * NUP), c2 = z2 ? zz : *(const v4u*)(rb + (ptrdiff_t)s2 * NUP + KDN);
            const float g0[8] = {pg8::bf_lo(a0.x), pg8::bf_hi(a0.x), pg8::bf_lo(a0.y), pg8::bf_hi(a0.y), pg8::bf_lo(a0.z), pg8::bf_hi(a0.z), pg8::bf_lo(a0.w), pg8::bf_hi(a0.w)};
            const float g1[8] = {pg8::bf_lo(a1.x), pg8::bf_hi(a1.x), pg8::bf_lo(a1.y), pg8::bf_hi(a1.y), pg8::bf_lo(a1.z), pg8::bf_hi(a1.z), pg8::bf_lo(a1.w), pg8::bf_hi(a1.w)};
            const float g2[8] = {pg8::bf_lo(a2.x), pg8::bf_hi(a2.x), pg8::bf_lo(a2.y), pg8::bf_hi(a2.y), pg8::bf_lo(a2.z), pg8::bf_hi(a2.z), pg8::bf_lo(a2.w), pg8::bf_hi(a2.w)};
            const float v0[8] = {pg8::bf_lo(c0.x), pg8::bf_hi(c0.x), pg8::bf_lo(c0.y), pg8::bf_hi(c0.y), pg8::bf_lo(c0.z), pg8::bf_hi(c0.z), pg8::bf_lo(c0.w), pg8::bf_hi(c0.w)};
            const float v1[8] = {pg8::bf_lo(c1.x), pg8::bf_hi(c1.x), pg8::bf_lo(c1.y), pg8::bf_hi(c1.y), pg8::bf_lo(c1.z), pg8::bf_hi(c1.z), pg8::bf_lo(c1.w), pg8::bf_hi(c1.w)};
            const float v2[8] = {pg8::bf_lo(c2.x), pg8::bf_hi(c2.x), pg8::bf_lo(c2.y), pg8::bf_hi(c2.y), pg8::bf_lo(c2.z), pg8::bf_hi(c2.z), pg8::bf_lo(c2.w), pg8::bf_hi(c2.w)};
            float o[8];
#pragma unroll
            for (int i = 0; i < 8; ++i) { const float cgt = cw[j + i] * g2[i] + cw[DFF2 + j + i] * g1[i] + cw[2 * DFF2 + j + i] * g0[i] + cb[j + i];
                const float cvl = cw[DFF + j + i] * v2[i] + cw[DFF2 + DFF + j + i] * v1[i] + cw[2 * DFF2 + DFF + j + i] * v0[i] + cb[DFF + j + i];
                o[i] = cgt * pg8::fast_sigmoid(cgt) * cvl; }
            v4u w; w.x = pk2(o[0], o[1]); w.y = pk2(o[2], o[3]); w.z = pk2(o[4], o[5]); w.w = pk2(o[6], o[7]);
            *(v4u*)ap = w; }
    }
    xcd_barrier(bar);
    {
        pg8::Gemm g{ACT, Wdn_t, KDN, KDN, KDN, 0, 0}; pg8::StaticOrder S; S.init(M, 1024, G, bx);
        pg8::EpiResB E{XN, out};
        pg8::gemm_phase<pg8::EpiResB, pg8::StaticOrder, true, true>(ldsp, g, S, E, widx);
    }
}

extern "C" void kernel_launch(void* const* d_in, const int* in_sizes, int n_in, void* d_out, int out_size, void* d_ws, size_t ws_size, hipStream_t stream) {
    static int grid = 0;
    if (grid == 0) {
        if (n_in != 24 || out_size != M * DM || ws_size < WS_END) { fprintf(stderr, "kernel_launch: unexpected problem (n_in %d, out %d, ws %zu); nothing launched\n", n_in, out_size, ws_size); grid = -1; return; }
        int dev = 0, cus = 0, per_cu = 0;
        if (hipGetDevice(&dev) != hipSuccess || hipDeviceGetAttribute(&cus, hipDeviceAttributeMultiprocessorCount, dev) != hipSuccess) { grid = -1; return; }
        if (hipFuncSetAttribute((const void*)hymba_fwd, hipFuncAttributeMaxDynamicSharedMemorySize, LDS_BYTES) != hipSuccess) { fprintf(stderr, "kernel_launch: hipFuncSetAttribute failed\n"); grid = -1; return; }
        if (hipOccupancyMaxActiveBlocksPerMultiprocessor(&per_cu, (const void*)hymba_fwd, NWAVES * 64, LDS_BYTES) != hipSuccess || per_cu < 1) { fprintf(stderr, "kernel_launch: occupancy query says %d blocks per CU\n", per_cu); per_cu = 1; }
        (void)hipGetLastError();
        if (cus != 256) { fprintf(stderr, "kernel_launch: built for a 256-CU device (got %d); nothing launched\n", cus); grid = -1; return; }
        grid = cus;
    }
    if (grid < 0) return;
    if (hipMemsetAsync((char*)d_ws + WS_CTL, 0, 16384, stream) != hipSuccess) { fprintf(stderr, "kernel_launch: hipMemsetAsync of the barrier words failed\n"); return; }
    Args a{};
    for (int i = 0; i < 24; ++i) a.in[i] = (const float*)d_in[i];
    a.out = (float*)d_out; a.ws = (unsigned char*)d_ws;
    void* kargs[] = {&a};
    const hipError_t e = hipLaunchCooperativeKernel((const void*)hymba_fwd, dim3(grid), dim3(NWAVES * 64), kargs, LDS_BYTES, stream);
    if (e != hipSuccess) fprintf(stderr, "kernel_launch: cooperative launch failed: %s (grid %d)\n", hipGetErrorString(e), grid);
}
```
